# Optimizing an MI355X kernel written in HIP

```python
import jax, jax.numpy as jnp
from jax import lax
import numpy as np

D_MODEL = 1024
BATCH = 2
SEQ = 8192
DEPTH = 2

GRID_W = 64
EPS = 1e-6

A_HEADS = 8
A_HEAD_DIM = D_MODEL // 16
A_WIDTH = A_HEADS * A_HEAD_DIM
CONV_WIDTH = 3
B_GROUPS = 4
B_GROUP_DIM = D_MODEL // 8
B_WIDTH = B_GROUPS * B_GROUP_DIM
EVEN_IN = 4 * A_WIDTH + 2 * B_WIDTH
EVEN_MIX = A_WIDTH + B_WIDTH

HEAD_DIM = 128
N_HEADS = D_MODEL // HEAD_DIM
N_KV_HEADS = N_HEADS // 4
Q_WIDTH = N_HEADS * HEAD_DIM
KV_WIDTH = N_KV_HEADS * HEAD_DIM
ODD_IN = 2 * Q_WIDTH + 2 * KV_WIDTH
ROPE_THETA = 10000.0
Q_BLOCK = 128

N_EVEN = (DEPTH + 1) // 2
N_ODD = DEPTH // 2

kernel_name = "hybrid_shortconv_fourier_axial_gqa_encoder"


def rms_norm(x, g):
    xf = x.astype(jnp.float32)
    y = xf * lax.rsqrt(jnp.mean(xf * xf, axis=-1, keepdims=True) + EPS)
    return (y * g.astype(jnp.float32)).astype(x.dtype)


def centred_depthwise_conv(u, w):
    s = u.shape[1]
    pad = CONV_WIDTH // 2
    up = jnp.pad(u, ((0, 0), (pad, CONV_WIDTH - 1 - pad), (0, 0)))
    out = up[:, 0:s] * w[0]
    for tap in range(1, CONV_WIDTH):
        out = out + up[:, tap:tap + s] * w[tap]
    return out


def short_conv_fourier_mixer(h, w_in, conv_w, w_out):
    bsz, s, _ = h.shape
    proj = h @ w_in
    a_x, a_b, a_c, a_z, b_u, b_z = jnp.split(
        proj,
        [A_WIDTH, 2 * A_WIDTH, 3 * A_WIDTH, 4 * A_WIDTH, 4 * A_WIDTH + B_WIDTH],
        axis=-1)
    y_a = a_b * centred_depthwise_conv(a_c * a_x, conv_w) * jax.nn.silu(a_z)
    u = b_u.reshape(bsz, s, B_GROUPS, B_GROUP_DIM).astype(jnp.float32)
    f = jnp.fft.fft2(u, axes=(1, 3), norm="ortho").real
    y_b = f.reshape(bsz, s, B_WIDTH).astype(h.dtype) * jax.nn.silu(b_z)
    return jnp.concatenate([y_a, y_b], axis=-1) @ w_out


def axial_rope_tables(s):
    rows = s // GRID_W
    row = jnp.repeat(jnp.arange(rows), GRID_W).astype(jnp.float32)
    col = jnp.tile(jnp.arange(GRID_W), rows).astype(jnp.float32)
    n_pair = HEAD_DIM // 4
    inv = ROPE_THETA ** (-jnp.arange(n_pair, dtype=jnp.float32) / n_pair)
    ang = jnp.concatenate([row[:, None] * inv, col[:, None] * inv], axis=-1)
    return jnp.cos(ang), jnp.sin(ang)


def apply_rope(x, cos, sin):
    xf = x.astype(jnp.float32).reshape(x.shape[:-1] + (HEAD_DIM // 2, 2))
    x1, x2 = xf[..., 0], xf[..., 1]
    c = cos[None, :, None, :]
    sn = sin[None, :, None, :]
    out = jnp.stack([x1 * c - x2 * sn, x1 * sn + x2 * c], axis=-1)
    return out.reshape(x.shape).astype(x.dtype)


def gqa_axial_mixer(h, w_in, q_gain, k_gain, w_out):
    bsz, s, _ = h.shape
    proj = h @ w_in
    q, k, v, z = jnp.split(
        proj, [Q_WIDTH, Q_WIDTH + KV_WIDTH, Q_WIDTH + 2 * KV_WIDTH], axis=-1)
    q = q.reshape(bsz, s, N_HEADS, HEAD_DIM)
    k = k.reshape(bsz, s, N_KV_HEADS, HEAD_DIM)
    v = v.reshape(bsz, s, N_KV_HEADS, HEAD_DIM)
    cos, sin = axial_rope_tables(s)
    q = apply_rope(rms_norm(q, q_gain), cos, sin)
    k = apply_rope(rms_norm(k, k_gain), cos, sin)
    groups = N_HEADS // N_KV_HEADS
    n_blk = s // Q_BLOCK
    qb = q.reshape(bsz, n_blk, Q_BLOCK, N_KV_HEADS, groups, HEAD_DIM).transpose(1, 0, 3, 4, 2, 5)
    kt = k.transpose(0, 2, 1, 3)
    vt = v.transpose(0, 2, 1, 3)
    scale = HEAD_DIM ** -0.5

    def attend_block(q_blk):
        sc = jnp.einsum('bkgqd,bksd->bkgqs', q_blk, kt,
                        preferred_element_type=jnp.float32) * scale
        p = jax.nn.softmax(sc, axis=-1)
        return jnp.einsum('bkgqs,bksd->bkgqd', p.astype(vt.dtype), vt)

    o = lax.map(attend_block, qb)
    o = o.transpose(1, 0, 4, 2, 3, 5).reshape(bsz, s, Q_WIDTH)
    return (o * jax.nn.silu(z)) @ w_out


def setup_inputs(seed: int = 0) -> dict:
    key = jax.random.key(seed)
    ks = jax.random.split(key, 12)
    f32 = jnp.float32
    x = jax.random.normal(ks[0], (BATCH, SEQ, D_MODEL), f32)
    norm_even = 1.0 + 0.02 * jax.random.normal(ks[1], (N_EVEN, D_MODEL), f32)
    w_in_even = jax.random.normal(ks[2], (N_EVEN, D_MODEL, EVEN_IN), f32) * D_MODEL ** -0.5
    conv_w = jax.random.normal(ks[3], (N_EVEN, CONV_WIDTH, A_WIDTH), f32) * CONV_WIDTH ** -0.5
    w_out_even = jax.random.normal(ks[4], (N_EVEN, EVEN_MIX, D_MODEL), f32) * EVEN_MIX ** -0.5
    norm_odd = 1.0 + 0.02 * jax.random.normal(ks[5], (N_ODD, D_MODEL), f32)
    w_in_odd = jax.random.normal(ks[6], (N_ODD, D_MODEL, ODD_IN), f32) * D_MODEL ** -0.5
    q_gain = 1.0 + 0.02 * jax.random.normal(ks[7], (N_ODD, HEAD_DIM), f32)
    k_gain = 1.0 + 0.02 * jax.random.normal(ks[8], (N_ODD, HEAD_DIM), f32)
    w_out_odd = jax.random.normal(ks[9], (N_ODD, Q_WIDTH, D_MODEL), f32) * Q_WIDTH ** -0.5
    final_norm = 1.0 + 0.02 * jax.random.normal(ks[10], (D_MODEL,), f32)
    return {"x": x, "norm_even": norm_even, "w_in_even": w_in_even, "conv_w": conv_w,
            "w_out_even": w_out_even, "norm_odd": norm_odd, "w_in_odd": w_in_odd,
            "q_gain": q_gain, "k_gain": k_gain, "w_out_odd": w_out_odd,
            "final_norm": final_norm}


def reference(x, norm_even, w_in_even, conv_w, w_out_even, norm_odd, w_in_odd,
              q_gain, k_gain, w_out_odd, final_norm):
    for layer in range(DEPTH):
        i = layer // 2
        if layer % 2 == 0:
            x = x + short_conv_fourier_mixer(rms_norm(x, norm_even[i]), w_in_even[i],
                                             conv_w[i], w_out_even[i])
        else:
            x = x + gqa_axial_mixer(rms_norm(x, norm_odd[i]), w_in_odd[i],
                                    q_gain[i], k_gain[i], w_out_odd[i])
    return rms_norm(x, final_norm)
```

```cpp
#include <hip/hip_runtime.h>
#include <hip/hip_cooperative_groups.h>
#include <hip/hip_bf16.h>
#include <cstdio>
#include <cstdint>
#include <cmath>
#define MK_ONE_LAUNCH 0
namespace pg8 {
#define PG8_LAS __attribute__((address_space(3)))
typedef unsigned short bf16_t;
typedef short bf16x8 __attribute__((ext_vector_type(8)));
typedef float f32x4 __attribute__((ext_vector_type(4)));
typedef unsigned u32x4 __attribute__((ext_vector_type(4)));
constexpr int BM = 256, BK = 64, HALF = 128, HTB = HALF * BK * 2  , STAGE_BYTES = 8 * HTB, NXCD = 8, WGM = 8;

__host__ __device__ __forceinline__ int lds_byte(int r, int c) { const int st = (r >> 4) * 2 + (c >> 5), rr = r & 15, cc = c & 31, ob = rr * 64 + cc * 2; return st * 1024 + (ob ^ (((ob >> 9) & 1) << 5)); }
__host__ __device__ __forceinline__ void stage_rc(int b, int& R, int& C) { const int st = b / 1024, sb = b % 1024, swz = sb ^ (((sb >> 9) & 1) << 5); R = (st >> 1) * 16 + swz / 64; C = (st & 1) * 32 + (swz % 64) / 2; }
__host__ __device__ __forceinline__ int perm32(int rho) { const int n = rho >> 4, i = rho & 15; return 8 * (i >> 2) + 4 * n + (i & 3); }

struct Unit { int pm, pn; };
struct Gemm { const bf16_t* A; const bf16_t* Bt; int M, N, K; };

struct StaticOrder {
    int nM, nN, nwg, G, c;
    __host__ __device__ void init(int M, int N, int G_, int c_) { nM = M / BM; nN = N / BM; nwg = nM * nN; G = G_; c = c_; }
    __host__ __device__ bool next(int i, Unit& u) const {
        const long L = (long)i * G + c; if (L >= nwg) return false;
        int wgid = (int)L; { const int q = nwg / NXCD, r = nwg % NXCD, xcd = wgid % NXCD, off = wgid / NXCD; wgid = (xcd < r ? xcd * (q + 1) : r * (q + 1) + (xcd - r) * q) + off; }
        const int nig = WGM * nN, gid = wgid / nig, fm = gid * WGM, gsz = (nM - fm) < WGM ? (nM - fm) : WGM;
        u.pm = fm + ((wgid % nig) % gsz); u.pn = (wgid % nig) / gsz; return true;
    }
    __device__ __forceinline__ void a_ready(const Unit&) const {}
    __device__ __forceinline__ void done(const Unit&) const {}
};

__device__ __forceinline__ unsigned cvt_pk_bf16(float lo, float hi) { unsigned r; asm volatile("v_cvt_pk_bf16_f32 %0, %1, %2" : "=v"(r) : "v"(lo), "v"(hi)); return r; }
__device__ __forceinline__ unsigned pk_f16(float lo, float hi) { const _Float16 a = (_Float16)lo, b = (_Float16)hi; return (unsigned)__builtin_bit_cast(unsigned short, a) | ((unsigned)__builtin_bit_cast(unsigned short, b) << 16); }
struct EpiScale {
    static constexpr bool PERM = true, AFTER_DRAIN = false;
    bf16_t* O; int ldc; const float* ssp; int f16_lo, f16_hi; float eps;
    __device__ __forceinline__ void operator()(const f32x4 (&acc)[2][2][4][2], const Unit& u, int wr, int wc, int fr, int fq) const {
        const int row0 = u.pm * BM + wr * 64 + fr, colt = u.pn * BM, col0 = colt + wc * 32 + 8 * fq;
        const bool h16 = (colt >= f16_lo) && (colt < f16_hi);
#pragma unroll
        for (int ai = 0; ai < 2; ++ai)
#pragma unroll
            for (int m = 0; m < 4; ++m) { const int row = row0 + ai * HALF + m * 16; float sc = 1.f;
                if (ssp) { const f32x4* sp = (const f32x4*)(ssp + (size_t)row * 16); const f32x4 a = sp[0], b = sp[1], c = sp[2], d = sp[3];
                    const float s = ((a[0] + a[1]) + (a[2] + a[3])) + ((b[0] + b[1]) + (b[2] + b[3])) + ((c[0] + c[1]) + (c[2] + c[3])) + ((d[0] + d[1]) + (d[2] + d[3]));
                    sc = 1.0f / sqrtf(s * (1.0f / 1024.0f) + eps); }
                bf16_t* rowp = O + (size_t)row * ldc + col0;
#pragma unroll
                for (int bj = 0; bj < 2; ++bj) { const f32x4 v0 = acc[ai][bj][m][0] * sc, v1 = acc[ai][bj][m][1] * sc; u32x4 w;
                    if (h16) { w.x = pk_f16(v0[0], v0[1]); w.y = pk_f16(v0[2], v0[3]); w.z = pk_f16(v1[0], v1[1]); w.w = pk_f16(v1[2], v1[3]); }
                    else { w.x = cvt_pk_bf16(v0[0], v0[1]); w.y = cvt_pk_bf16(v0[2], v0[3]); w.z = cvt_pk_bf16(v1[0], v1[1]); w.w = cvt_pk_bf16(v1[2], v1[3]); }
                    *(u32x4*)(rowp + bj * HALF) = w; } }
    }
};
struct EpiResid {
    static constexpr bool PERM = false, AFTER_DRAIN = false;
    const float* base; float* out; bf16_t* xg; const float* gain; float* ssp; int ldc;
    __device__ __forceinline__ void operator()(const f32x4 (&acc)[2][2][4][2], const Unit& u, int wr, int wc, int fr, int fq) const {
        typedef unsigned u32x2v __attribute__((ext_vector_type(2)));
        const int col0 = u.pn * BM + wc * 32 + 4 * fq;
#pragma unroll
        for (int ai = 0; ai < 2; ++ai)
#pragma unroll
            for (int m = 0; m < 4; ++m) { const int row = u.pm * BM + ai * HALF + wr * 64 + m * 16 + fr; const size_t off = (size_t)row * ldc + col0; float s = 0.f;
#pragma unroll
                for (int bj = 0; bj < 2; ++bj)
#pragma unroll
                    for (int n = 0; n < 2; ++n) { const int co = bj * HALF + n * 16; const f32x4 bs = *(const f32x4*)(base + off + co); const f32x4 o = bs + acc[ai][bj][m][n];
                        *(f32x4*)(out + off + co) = o; s += (o[0] * o[0] + o[1] * o[1]) + (o[2] * o[2] + o[3] * o[3]);
                        if (xg) { const f32x4 g = *(const f32x4*)(gain + col0 + co); u32x2v w; w.x = cvt_pk_bf16(o[0] * g[0], o[1] * g[1]); w.y = cvt_pk_bf16(o[2] * g[2], o[3] * g[3]); *(u32x2v*)(xg + off + co) = w; } }
                if (ssp) { s += __shfl_xor(s, 16); s += __shfl_xor(s, 32); if (fq == 0) ssp[(size_t)row * 16 + u.pn * 4 + wc] = s; } }
    }
};

template <class Epi, class Sched, bool ALIGN_EPI = false, bool SP2 = false>
__device__ __forceinline__ void gemm_phase(PG8_LAS unsigned char* lds, const Gemm g, const Sched& S, const Epi& E) {
    const int tid = threadIdx.x, wid = __builtin_amdgcn_readfirstlane(tid >> 6), lane = tid & 63, wr = wid >> 2, wc = wid & 3, fr = lane & 15, fq = lane >> 4;
    const int K = g.K, nt = K / BK;
    unsigned voffA[2], voffB[2];
#pragma unroll
    for (int i = 0; i < 2; ++i) { int R, C; stage_rc(tid * 16 + i * 8192, R, C); const int Rb = Epi::PERM ? ((R & ~31) + perm32(R & 31)) : R;
        voffA[i] = (unsigned)(R * K + C) * 2u; voffB[i] = (unsigned)(Rb * K + C) * 2u; }
    const size_t kstep = (size_t)(BK * 2);
    const size_t hstep = (size_t)HALF * K * 2;
    const size_t tstep = 2 * hstep;
    const unsigned ldsw = (unsigned)wid * 1024u;
    const int aoff = lds_byte(wr * 64 + fr, fq * 8), boff = lds_byte(wc * 32 + fr, fq * 8);
#define PG8_SA(b, h) (((b) * 2 + (h)) * HTB)
#define PG8_SB(b, h) ((4 + (b) * 2 + (h)) * HTB)
#define PG8_STAGE(bufoff, gbase, voff) do { _Pragma("unroll") for (int _i = 0; _i < 2; ++_i) \
        __builtin_amdgcn_global_load_lds((const unsigned*)((const char*)(gbase) + (voff)[_i]), (PG8_LAS unsigned*)(lds + (bufoff) + ldsw + _i * 8192), 16, 0, 0); } while (0)
#define PG8_LDA(dst, b, h) do { _Pragma("unroll") for (int m = 0; m < 4; ++m) _Pragma("unroll") for (int k = 0; k < 2; ++k) dst[m][k] = *(const PG8_LAS bf16x8*)(lds + PG8_SA(b, h) + aoff + m * 2048 + k * 1024); } while (0)
#define PG8_LDB(dst, b, h) do { _Pragma("unroll") for (int n = 0; n < 2; ++n) _Pragma("unroll") for (int k = 0; k < 2; ++k) dst[n][k] = *(const PG8_LAS bf16x8*)(lds + PG8_SB(b, h) + boff + n * 2048 + k * 1024); } while (0)
#define PG8_MMA(ai, bj, At, Bt) do { __builtin_amdgcn_s_setprio(1); _Pragma("unroll") for (int m = 0; m < 4; ++m) _Pragma("unroll") for (int n = 0; n < 2; ++n) _Pragma("unroll") for (int k = 0; k < 2; ++k) \
        acc[ai][bj][m][n] = __builtin_amdgcn_mfma_f32_16x16x32_bf16(Bt[n][k], At[m][k], acc[ai][bj][m][n], 0, 0, 0); __builtin_amdgcn_s_setprio(0); } while (0)
#define PG8_WAIT_V(n) asm volatile("s_waitcnt vmcnt(" #n ")" ::: "memory")
#define PG8_WAIT_L(n) asm volatile("s_waitcnt lgkmcnt(" #n ")" ::: "memory")
#define PG8_BAR __builtin_amdgcn_s_barrier()
#define PG8_SCHED __builtin_amdgcn_sched_barrier(0)
    Unit cur, nxt; int ui = 0;
    if (!S.next(0, cur)) return;
    f32x4 acc[2][2][4][2];
#pragma unroll
    for (int a = 0; a < 2; ++a)
#pragma unroll
        for (int b = 0; b < 2; ++b)
#pragma unroll
            for (int m = 0; m < 4; ++m)
#pragma unroll
                for (int n = 0; n < 2; ++n) acc[a][b][m][n] = (f32x4){0.f, 0.f, 0.f, 0.f};
    bf16x8 At[4][2], B0[2][2], B1[2][2];
    const char* cA = (const char*)g.A + (size_t)cur.pm * tstep; const char* cB = (const char*)g.Bt + (size_t)cur.pn * tstep;
    S.a_ready(cur);
    if constexpr (SP2) {
        PG8_STAGE(PG8_SB(0, 0), cB, voffB); PG8_STAGE(PG8_SB(0, 1), cB + hstep, voffB); PG8_STAGE(PG8_SA(0, 0), cA, voffA); PG8_STAGE(PG8_SA(0, 1), cA + hstep, voffA);
        if (wr == 1) PG8_BAR;
        PG8_WAIT_V(2); PG8_BAR;
        PG8_STAGE(PG8_SB(1, 0), cB + kstep, voffB); PG8_STAGE(PG8_SA(1, 0), cA + kstep, voffA); PG8_STAGE(PG8_SB(1, 1), cB + hstep + kstep, voffB);
        PG8_WAIT_V(6); PG8_BAR;
    } else {
        PG8_STAGE(PG8_SB(0, 0), cB, voffB); PG8_STAGE(PG8_SA(0, 0), cA, voffA); PG8_STAGE(PG8_SB(0, 1), cB + hstep, voffB); PG8_STAGE(PG8_SA(0, 1), cA + hstep, voffA);
        if (wr == 1) PG8_BAR;
        PG8_WAIT_V(4); PG8_BAR;
        PG8_STAGE(PG8_SB(1, 0), cB + kstep, voffB); PG8_STAGE(PG8_SA(1, 0), cA + kstep, voffA); PG8_STAGE(PG8_SB(1, 1), cB + hstep + kstep, voffB);
        PG8_WAIT_V(6); PG8_BAR;
    }
    for (;;) {
        const bool has_next = S.next(ui + 1, nxt);
        const char* nA = has_next ? (const char*)g.A + (size_t)nxt.pm * tstep : cA; const char* nB = has_next ? (const char*)g.Bt + (size_t)nxt.pn * tstep : cB;
        for (int t = 0; t < nt; t += 2) {
            const bool last = (t == nt - 2);
            const char* a1 = cA + (size_t)(t + 1) * kstep;
            const char* a2 = last ? nA : cA + (size_t)(t + 2) * kstep; const char* b2 = last ? nB : cB + (size_t)(t + 2) * kstep;
            const char* a3 = a2 + kstep; const char* b3 = b2 + kstep;
            if (last && has_next) S.a_ready(nxt);
            if constexpr (SP2) {
            PG8_LDB(B0, 0, 0); PG8_LDB(B1, 0, 1); PG8_SCHED; PG8_LDA(At, 0, 0); PG8_STAGE(PG8_SA(1, 1), a1 + hstep, voffA);
            PG8_WAIT_V(8); PG8_WAIT_L(0); PG8_BAR; PG8_MMA(0, 0, At, B0); PG8_MMA(0, 1, At, B1); PG8_BAR; PG8_SCHED;
            PG8_LDA(At, 0, 1); PG8_STAGE(PG8_SB(0, 0), b2, voffB); PG8_STAGE(PG8_SB(0, 1), b2 + hstep, voffB); PG8_STAGE(PG8_SA(0, 0), a2, voffA);
            PG8_WAIT_V(8); PG8_WAIT_L(0); PG8_BAR; PG8_MMA(1, 0, At, B0); PG8_MMA(1, 1, At, B1); PG8_BAR; PG8_SCHED;
            PG8_LDB(B0, 1, 0); PG8_LDB(B1, 1, 1); PG8_SCHED; PG8_LDA(At, 1, 0); PG8_STAGE(PG8_SA(0, 1), a2 + hstep, voffA);
            PG8_WAIT_V(8); PG8_WAIT_L(0); PG8_BAR; PG8_MMA(0, 0, At, B0); PG8_MMA(0, 1, At, B1); PG8_BAR; PG8_SCHED;
            PG8_LDA(At, 1, 1); PG8_STAGE(PG8_SB(1, 0), b3, voffB); PG8_STAGE(PG8_SB(1, 1), b3 + hstep, voffB); PG8_STAGE(PG8_SA(1, 0), a3, voffA);
            PG8_WAIT_V(8); PG8_WAIT_L(0); PG8_BAR; PG8_MMA(1, 0, At, B0); PG8_MMA(1, 1, At, B1); PG8_BAR; PG8_SCHED;
            } else {
            PG8_LDB(B0, 0, 0); PG8_SCHED; PG8_LDA(At, 0, 0); PG8_STAGE(PG8_SA(1, 1), a1 + hstep, voffA);
            PG8_WAIT_L(8); PG8_BAR; PG8_WAIT_L(0); PG8_MMA(0, 0, At, B0); PG8_BAR; PG8_SCHED;
            PG8_LDB(B1, 0, 1); PG8_STAGE(PG8_SB(0, 0), b2, voffB);
            PG8_BAR; PG8_WAIT_L(0); PG8_MMA(0, 1, At, B1); PG8_BAR;
            PG8_LDA(At, 0, 1); PG8_STAGE(PG8_SA(0, 0), a2, voffA);
            PG8_BAR; PG8_WAIT_L(0); PG8_MMA(1, 0, At, B0); PG8_BAR; PG8_SCHED;
            PG8_STAGE(PG8_SB(0, 1), b2 + hstep, voffB);
            PG8_WAIT_V(6); PG8_BAR; PG8_MMA(1, 1, At, B1); PG8_BAR;
            PG8_LDB(B0, 1, 0); PG8_SCHED; PG8_LDA(At, 1, 0); PG8_STAGE(PG8_SA(0, 1), a2 + hstep, voffA);
            PG8_WAIT_L(8); PG8_BAR; PG8_WAIT_L(0); PG8_MMA(0, 0, At, B0); PG8_BAR; PG8_SCHED;
            PG8_LDB(B1, 1, 1); PG8_STAGE(PG8_SB(1, 0), b3, voffB);
            PG8_BAR; PG8_WAIT_L(0); PG8_MMA(0, 1, At, B1); PG8_BAR;
            PG8_LDA(At, 1, 1); PG8_STAGE(PG8_SA(1, 0), a3, voffA);
            PG8_BAR; PG8_WAIT_L(0); PG8_MMA(1, 0, At, B0); PG8_BAR; PG8_SCHED;
            PG8_STAGE(PG8_SB(1, 1), b3 + hstep, voffB);
            PG8_WAIT_V(6); PG8_BAR; PG8_MMA(1, 1, At, B1); PG8_BAR;
            }
        }
        if constexpr (ALIGN_EPI) { if (wr == 0) PG8_BAR; }
        if constexpr (!Epi::AFTER_DRAIN) { E(acc, cur, wr, wc, fr, fq); S.done(cur); }
        if (!has_next) break;
#pragma unroll
        for (int a = 0; a < 2; ++a)
#pragma unroll
            for (int b = 0; b < 2; ++b)
#pragma unroll
                for (int m = 0; m < 4; ++m)
#pragma unroll
                    for (int n = 0; n < 2; ++n) acc[a][b][m][n] = (f32x4){0.f, 0.f, 0.f, 0.f};
        cur = nxt; cA = nA; cB = nB; ++ui;
        if constexpr (ALIGN_EPI) { if (wr == 1) PG8_BAR; }
    }
    PG8_WAIT_V(0);
    if constexpr (!ALIGN_EPI) { if (wr == 0) PG8_BAR; }
    PG8_BAR;
    if constexpr (Epi::AFTER_DRAIN) { E.fused(acc, cur, wr, wc, fr, fq, lds, wid, lane); S.done(cur); }
#undef PG8_SA
#undef PG8_SB
#undef PG8_STAGE
#undef PG8_LDA
#undef PG8_LDB
#undef PG8_MMA
#undef PG8_WAIT_V
#undef PG8_WAIT_L
#undef PG8_BAR
#undef PG8_SCHED
}
}

namespace att {
using bf16 = __hip_bfloat16;
constexpr int   D = 128, NW = 8, QBLK = 32, KVBLK = 64;
constexpr float SCALE = 0.088388347648318440f;
constexpr float THR = 8.f;
constexpr int SDEPTH = 2;
constexpr int LDQ = 2560, LDK = 2560, LDZ = 2560, LDO = 1024;
constexpr size_t SHM_V = KVBLK * D * 2, SHM_K = KVBLK * D * 2, SHM_ATTN = 2 * SHM_V + 2 * SHM_K + NW * 64 * 4;
using bf16x8 = __attribute__((ext_vector_type(8))) short;
using s16x4  = __attribute__((ext_vector_type(4))) short;
using f32x16 = __attribute__((ext_vector_type(16))) float;
using f32x8  = __attribute__((ext_vector_type(8))) float;
using u32x4  = __attribute__((ext_vector_type(4))) unsigned;
#define KSWZ(row, colB) ((row) * 256 + ((colB) ^ (((row) & 7) << 4)))
#define SBAR() __builtin_amdgcn_sched_barrier(0)
__device__ __forceinline__ int crow(int r, int hi) { return (r & 3) + 8 * (r >> 2) + 4 * hi; }
__device__ __forceinline__ unsigned cvtpk(float lo, float hi) {
  unsigned r; asm volatile("v_cvt_pk_bf16_f32 %0, %1, %2" : "=v"(r) : "v"(lo), "v"(hi)); return r;
}
template <typename TIn> struct Stage;
template <> struct Stage<bf16>  { using T = bf16x8;
  __device__ static __forceinline__ T ld8(const bf16* p) { return *reinterpret_cast<const bf16x8*>(p); }
  __device__ static __forceinline__ bf16x8 tobf(T x) { return x; } };
template <> struct Stage<float> { using T = f32x8;
  __device__ static __forceinline__ T ld8(const float* p) { return *reinterpret_cast<const f32x8*>(p); }
  __device__ static __forceinline__ bf16x8 tobf(T x) {
    u32x4 w = {cvtpk(x[0], x[1]), cvtpk(x[2], x[3]), cvtpk(x[4], x[5]), cvtpk(x[6], x[7])}; return *reinterpret_cast<bf16x8*>(&w); } };

__device__ __forceinline__ void partialSM(f32x16& p0, f32x16& p1, float& m_reg, float& mn, float& alpha) {
  constexpr float C = SCALE * 1.4426950408889634f;
  float pmax = p0[0]; for (int r = 1; r < 16; ++r) pmax = fmaxf(pmax, p0[r]); for (int r = 0; r < 16; ++r) pmax = fmaxf(pmax, p1[r]);
  { auto rr = __builtin_amdgcn_permlane32_swap(__float_as_uint(pmax), __float_as_uint(pmax), false, false);
    pmax = fmaxf(__uint_as_float(rr[0]), __uint_as_float(rr[1])); }
  if (__builtin_expect(__all(pmax - m_reg <= THR / SCALE), 1)) { mn = m_reg; alpha = 1.f; }
  else { mn = fmaxf(m_reg, pmax); alpha = __builtin_amdgcn_exp2f((m_reg - mn) * C); m_reg = mn; }
  float mnC = -mn * C;
  for (int r = 0; r < 16; ++r) p0[r] = fmaf(p0[r], C, mnC); for (int r = 0; r < 16; ++r) p1[r] = fmaf(p1[r], C, mnC);
  for (int r = 0; r < 16; ++r) p0[r] = __builtin_amdgcn_exp2f(p0[r]);
}
__device__ __forceinline__ void finishSM(f32x16& p0, f32x16& p1, float alpha, float& l_reg, bf16x8& pa0, bf16x8& pa1, bf16x8& pa2, bf16x8& pa3) {
  for (int r = 0; r < 16; ++r) p1[r] = __builtin_amdgcn_exp2f(p1[r]);
  float ps = 0; for (int r = 0; r < 16; ++r) ps += p0[r]; for (int r = 0; r < 16; ++r) ps += p1[r];
  { auto rr = __builtin_amdgcn_permlane32_swap(__float_as_uint(ps), __float_as_uint(ps), false, false);
    ps = __uint_as_float(rr[0]) + __uint_as_float(rr[1]); }
  l_reg = l_reg * alpha + ps;
#define PK4(P, BASE, OUT) do { unsigned a0 = cvtpk(P[BASE + 0], P[BASE + 1]), a1 = cvtpk(P[BASE + 2], P[BASE + 3]);   \
    unsigned b0 = cvtpk(P[BASE + 4], P[BASE + 5]), b1 = cvtpk(P[BASE + 6], P[BASE + 7]);                              \
    auto r0 = __builtin_amdgcn_permlane32_swap(a0, b0, false, false); auto r1 = __builtin_amdgcn_permlane32_swap(a1, b1, false, false); \
    u32x4 w = {r0[0], r1[0], r0[1], r1[1]}; OUT = *reinterpret_cast<bf16x8*>(&w); } while (0)
  PK4(p0, 0, pa0); PK4(p0, 8, pa1); PK4(p1, 0, pa2); PK4(p1, 8, pa3);
#undef PK4
}
__device__ __forceinline__ void qkt(f32x16& p0, f32x16& p1, const bf16* Ks, const bf16x8* qr, int r32, int hi) {
  p0 = f32x16{}; p1 = f32x16{};
  for (int d0 = 0; d0 < 8; ++d0) { int cb = (d0 * 16 + hi * 8) * 2;
    bf16x8 b0 = *reinterpret_cast<const bf16x8*>((const char*)Ks + KSWZ(r32, cb));
    bf16x8 b1 = *reinterpret_cast<const bf16x8*>((const char*)Ks + KSWZ(32 + r32, cb));
    p0 = __builtin_amdgcn_mfma_f32_32x32x16_bf16(b0, qr[d0], p0, 0, 0, 0);
    p1 = __builtin_amdgcn_mfma_f32_32x32x16_bf16(b1, qr[d0], p1, 0, 0, 0); }
}
__device__ __forceinline__ int v_st(int k, int c) { const int kk = (k & ~0xC) | ((k & 4) << 1) | ((k & 8) >> 1); return ((kk >> 3) * 4 + (c >> 5)) * 512 + ((kk & 7) * 32 + (c & 31)) * 2; }
__device__ __forceinline__ int v_rd_base(int lane) { return ((lane & 3) << 3) | (((lane >> 2) & 3) << 6) | (((lane >> 4) & 1) << 5) | (((lane >> 5) & 1) << 8); }
constexpr int v_rd_off(int d0, int ks, int half) { return d0 * 512 + ks * 4096 + half * 2048; }
template <int OFF> __device__ __forceinline__ s16x4 tr_read(int vb) {
  s16x4 r; asm volatile("ds_read_b64_tr_b16 %0, %1 offset:%2" : "=&v"(r) : "v"(vb), "i"(OFF) : "memory"); return r;
}
template <int D0> __device__ __forceinline__ void pv_one(f32x16& od, int vb, bf16x8 pa0, bf16x8 pa1, bf16x8 pa2, bf16x8 pa3) {
  const s16x4 l0 = tr_read<v_rd_off(D0, 0, 0)>(vb), h0 = tr_read<v_rd_off(D0, 0, 1)>(vb), l1 = tr_read<v_rd_off(D0, 1, 0)>(vb), h1 = tr_read<v_rd_off(D0, 1, 1)>(vb);
  const s16x4 l2 = tr_read<v_rd_off(D0, 2, 0)>(vb), h2 = tr_read<v_rd_off(D0, 2, 1)>(vb), l3 = tr_read<v_rd_off(D0, 3, 0)>(vb), h3 = tr_read<v_rd_off(D0, 3, 1)>(vb);
  asm volatile("s_waitcnt lgkmcnt(0)" ::: "memory"); SBAR();
#define PK(L, H) (bf16x8){L[0], L[1], L[2], L[3], H[0], H[1], H[2], H[3]}
  od = __builtin_amdgcn_mfma_f32_32x32x16_bf16(pa0, PK(l0, h0), od, 0, 0, 0);
  od = __builtin_amdgcn_mfma_f32_32x32x16_bf16(pa1, PK(l1, h1), od, 0, 0, 0);
  od = __builtin_amdgcn_mfma_f32_32x32x16_bf16(pa2, PK(l2, h2), od, 0, 0, 0);
  od = __builtin_amdgcn_mfma_f32_32x32x16_bf16(pa3, PK(l3, h3), od, 0, 0, 0);
#undef PK
}
__device__ __forceinline__ void pv_d0(f32x16* o, int vb, bf16x8 pa0, bf16x8 pa1, bf16x8 pa2, bf16x8 pa3) {
  pv_one<0>(o[0], vb, pa0, pa1, pa2, pa3); pv_one<1>(o[1], vb, pa0, pa1, pa2, pa3); pv_one<2>(o[2], vb, pa0, pa1, pa2, pa3); pv_one<3>(o[3], vb, pa0, pa1, pa2, pa3);
}
__device__ __forceinline__ void pv_one_f16(f32x16& od, int vb, bf16x8 pa0, bf16x8 pa1, bf16x8 pa2, bf16x8 pa3) {
  typedef _Float16 h8 __attribute__((ext_vector_type(8)));
  const s16x4 l0 = tr_read<v_rd_off(0, 0, 0)>(vb), h0 = tr_read<v_rd_off(0, 0, 1)>(vb), l1 = tr_read<v_rd_off(0, 1, 0)>(vb), h1 = tr_read<v_rd_off(0, 1, 1)>(vb);
  const s16x4 l2 = tr_read<v_rd_off(0, 2, 0)>(vb), h2 = tr_read<v_rd_off(0, 2, 1)>(vb), l3 = tr_read<v_rd_off(0, 3, 0)>(vb), h3 = tr_read<v_rd_off(0, 3, 1)>(vb);
  asm volatile("s_waitcnt lgkmcnt(0)" ::: "memory"); SBAR();
#define PKH(L, H) __builtin_bit_cast(h8, (bf16x8){L[0], L[1], L[2], L[3], H[0], H[1], H[2], H[3]})
  od = __builtin_amdgcn_mfma_f32_32x32x16_f16(__builtin_bit_cast(h8, pa0), PKH(l0, h0), od, 0, 0, 0);
  od = __builtin_amdgcn_mfma_f32_32x32x16_f16(__builtin_bit_cast(h8, pa1), PKH(l1, h1), od, 0, 0, 0);
  od = __builtin_amdgcn_mfma_f32_32x32x16_f16(__builtin_bit_cast(h8, pa2), PKH(l2, h2), od, 0, 0, 0);
  od = __builtin_amdgcn_mfma_f32_32x32x16_f16(__builtin_bit_cast(h8, pa3), PKH(l3, h3), od, 0, 0, 0);
#undef PKH
}
template <typename TQ_unused = void>
__device__ __forceinline__ void attn_dense_body(const bf16* __restrict__ Qb, const bf16* __restrict__ Kh, const bf16* __restrict__ Vh,
                                                const bf16* __restrict__ Zb, bf16* __restrict__ Ob, int seq, char* lds) {
  using TQ = bf16;
  using St = Stage<bf16>; using SQ = Stage<TQ>;
  int tid_ = threadIdx.x; asm volatile("" : "+v"(tid_));
  const int tid = tid_, wid = tid >> 6, lane = tid & 63, r32 = lane & 31, hi = lane >> 5;
  bf16* V_lds = (bf16*)lds; bf16* K_lds = (bf16*)(lds + 2 * SHM_V);
  float* ws = (float*)(lds + 2 * SHM_V + 2 * SHM_K) + wid * 64; float* li_l = ws; float* al_l = ws + 32;
  float m_reg = -1e30f, l_reg = 0; f32x16 o[4] = {}; bf16x8 qr[8];
  const TQ* Qw = Qb + (long)(wid * QBLK + r32) * LDQ + hi * 8;
#pragma unroll
  for (int d0 = 0; d0 < 8; ++d0) qr[d0] = SQ::tobf(SQ::ld8(Qw + d0 * 16));
  const int sr = tid >> 4, sc = (tid & 15) * 8, vst0 = v_st(sr, sc), vst1 = v_st(32 + sr, sc);
  const int vb0 = (int)(uintptr_t)V_lds + v_rd_base(lane);
  struct { typename St::T vs0, vs1, ks0, ks1; } sr_[SDEPTH];
#define SLOAD(i, k0) do { sr_[i].vs0 = St::ld8(&Vh[(long)((k0) + sr) * LDK + sc]); sr_[i].vs1 = St::ld8(&Vh[(long)((k0) + 32 + sr) * LDK + sc]); \
    sr_[i].ks0 = St::ld8(&Kh[(long)((k0) + sr) * LDK + sc]); sr_[i].ks1 = St::ld8(&Kh[(long)((k0) + 32 + sr) * LDK + sc]); } while (0)
#define SWRITE(b, i) do { *(bf16x8*)((char*)V_lds + (b) * SHM_V + vst0) = St::tobf(sr_[i].vs0);          \
    *(bf16x8*)((char*)V_lds + (b) * SHM_V + vst1) = St::tobf(sr_[i].vs1); int kc = sc * 2;               \
    *(bf16x8*)((char*)K_lds + (b) * SHM_K + KSWZ(sr, kc)) = St::tobf(sr_[i].ks0);                       \
    *(bf16x8*)((char*)K_lds + (b) * SHM_K + KSWZ(32 + sr, kc)) = St::tobf(sr_[i].ks1); } while (0)
#define SWAIT() do { if constexpr (SDEPTH == 2) asm volatile("s_waitcnt vmcnt(4)" ::: "memory"); else asm volatile("s_waitcnt vmcnt(0)" ::: "memory"); } while (0)
#define RESC(a) do { if (__any((a) < 1.f)) { if (hi == 0) al_l[r32] = (a); asm volatile("s_waitcnt lgkmcnt(0)" ::: "memory"); \
    for (int d = 0; d < 4; ++d) for (int r = 0; r < 16; ++r) o[d][r] *= al_l[crow(r, hi)]; } } while (0)
  f32x16 pA0, pA1, pB0, pB1; float mnA, mnB, alA, alB; bf16x8 pa0, pa1, pa2, pa3; const int NT = seq / KVBLK;
  constexpr int SE = 0, SO = SDEPTH - 1;
  SLOAD(SE, 0); asm volatile("s_waitcnt vmcnt(0)" ::: "memory"); SWRITE(0, SE); __syncthreads();
  qkt(pA0, pA1, K_lds, qr, r32, hi); partialSM(pA0, pA1, m_reg, mnA, alA);
  SLOAD(SO, KVBLK); if constexpr (SDEPTH == 2) { if (2 < NT) SLOAD(SE, 2 * KVBLK); }
  SWAIT(); SWRITE(1, SO); __syncthreads();
  for (int j = 1; j + 1 < NT; j += 2) {
    SBAR(); qkt(pB0, pB1, (bf16*)((char*)K_lds + SHM_K), qr, r32, hi);
    finishSM(pA0, pA1, alA, l_reg, pa0, pa1, pa2, pa3); SBAR();
    SLOAD(SO, (j + SDEPTH) * KVBLK); SBAR();
    pv_d0(o, vb0, pa0, pa1, pa2, pa3); partialSM(pB0, pB1, m_reg, mnB, alB);
    __syncthreads(); SWAIT(); SWRITE(0, SE);
    RESC(alB); __syncthreads();
    SBAR(); qkt(pA0, pA1, K_lds, qr, r32, hi);
    finishSM(pB0, pB1, alB, l_reg, pa0, pa1, pa2, pa3); SBAR();
    if (SDEPTH == 1 || j + 3 < NT) SLOAD(SE, (j + 1 + SDEPTH) * KVBLK); SBAR();
    pv_d0(o, vb0 + (int)SHM_V, pa0, pa1, pa2, pa3); partialSM(pA0, pA1, m_reg, mnA, alA);
    __syncthreads(); SWAIT(); SWRITE(1, SO);
    RESC(alA); __syncthreads();
  }
  SBAR(); qkt(pB0, pB1, (bf16*)((char*)K_lds + SHM_K), qr, r32, hi);
  finishSM(pA0, pA1, alA, l_reg, pa0, pa1, pa2, pa3); SBAR();
  pv_d0(o, vb0, pa0, pa1, pa2, pa3); partialSM(pB0, pB1, m_reg, mnB, alB);
  __syncthreads(); RESC(alB);
  finishSM(pB0, pB1, alB, l_reg, pa0, pa1, pa2, pa3); SBAR();
  pv_d0(o, vb0 + (int)SHM_V, pa0, pa1, pa2, pa3);
  if (hi == 0) li_l[r32] = l_reg; asm volatile("s_waitcnt lgkmcnt(0)" ::: "memory");
  float rli[16];
#pragma unroll
  for (int r = 0; r < 16; ++r) rli[r] = __builtin_amdgcn_rcpf(li_l[crow(r, hi)]);
  bf16* Ow = Ob + (long)(wid * QBLK) * LDO; const bf16* Zw = Zb + (long)(wid * QBLK) * LDZ;
#pragma unroll
  for (int rg = 0; rg < 4; ++rg) {
    float zv[4][4];
#pragma unroll
    for (int rr = 0; rr < 4; ++rr)
#pragma unroll
      for (int d0 = 0; d0 < 4; ++d0) zv[rr][d0] = __bfloat162float(Zw[(long)crow(4 * rg + rr, hi) * LDZ + d0 * 32 + r32]);
#pragma unroll
    for (int rr = 0; rr < 4; ++rr) { const int r = 4 * rg + rr, orow = crow(r, hi);
#pragma unroll
      for (int d0 = 0; d0 < 4; ++d0) { const float z = zv[rr][d0]; const float gte = z * __builtin_amdgcn_rcpf(1.f + __expf(-z));
        Ow[(long)orow * LDO + d0 * 32 + r32] = __float2bfloat16(o[d0][r] * rli[r] * gte); } }
    asm volatile("" ::: "memory");
  }
#undef SLOAD
#undef SWRITE
#undef SWAIT
#undef RESC
}
}

#define GAS __attribute__((address_space(1)))
#define LAS __attribute__((address_space(3)))
namespace cg = cooperative_groups;
typedef unsigned short u16;
typedef unsigned v4u __attribute__((ext_vector_type(4)));
typedef unsigned v2u __attribute__((ext_vector_type(2)));
typedef float f32x4 __attribute__((ext_vector_type(4)));
typedef float f32x2 __attribute__((ext_vector_type(2)));
typedef float f32x16 __attribute__((ext_vector_type(16)));
typedef short s16x8 __attribute__((ext_vector_type(8)));
typedef short s16x4 __attribute__((ext_vector_type(4)));
typedef _Float16 f16x8 __attribute__((ext_vector_type(8)));
#define LDS_WAIT() asm volatile("s_waitcnt lgkmcnt(0)" ::: "memory")

constexpr int NWAVES = 8, NTHR = 512;
constexpr int BATCH = 2, SEQ = 8192, DM = 1024, M = BATCH * SEQ, N0 = 3072, N1 = 2560;
constexpr float EPS = 1e-6f;
constexpr size_t MiB = 1u << 20, KiB = 1024;
constexpr size_t WS_CTL = 0, CTL_ZERO_BYTES = 64 * KiB;
constexpr int CW_BAR = 1024;
constexpr size_t WS_TFC = 1 * MiB, WS_T128 = WS_TFC + 64 * KiB, WS_TTW = WS_T128 + 64 * KiB, WS_T64 = WS_TTW + 64 * KiB, WS_TROPE = WS_T64 + 32 * KiB;
constexpr size_t WS_SSP = 2 * MiB;
constexpr size_t WS_W0IN = 3 * MiB, WS_W0OUT = 9 * MiB, WS_W1IN = 11 * MiB, WS_W1OUT = 16 * MiB;
constexpr size_t WS_XN = 18 * MiB;
constexpr size_t WS_PROJ = 50 * MiB;
constexpr size_t WS_ABUF = 146 * MiB;
constexpr size_t WS_YCAT = 178 * MiB;
constexpr size_t WS_END = 210 * MiB;
constexpr int RING_BYTES = 131072, MISC_OFF = RING_BYTES + 320, LDS_BYTES = 147456;

__device__ __forceinline__ unsigned f2bf(float f) { unsigned u = __builtin_bit_cast(unsigned, f); return (u + 0x7fffu + ((u >> 16) & 1u)) >> 16; }
__device__ __forceinline__ unsigned pk2(float lo, float hi) { return f2bf(lo) | (f2bf(hi) << 16); }
__device__ __forceinline__ float bflo(unsigned w) { return __builtin_bit_cast(float, w << 16); }
__device__ __forceinline__ float bfhi(unsigned w) { return __builtin_bit_cast(float, w & 0xffff0000u); }
__device__ __forceinline__ u16 f2h(float f) { const _Float16 h = (_Float16)f; return __builtin_bit_cast(u16, h); }
__device__ __forceinline__ float silu(float z) { return z / (1.f + __expf(-z)); }
__device__ __forceinline__ int crow(int r, int hi) { return (r & 3) + 8 * (r >> 2) + 4 * hi; }


#define XB_TMO      128
#define XB_XCNT(j)  (256  + 64 * (j))
#define XB_XSUB(j)  (1280 + 64 * (j))
#define XB_XGEN(j)  (2304 + 64 * (j))
#define XB_TOP      3328
#define XB_TOPGEN   3392
#define XCD_BAR_WORDS 3456
#define XB_SPIN_CAP (1u << 18)

__device__ __forceinline__ unsigned xb_ld(unsigned* p)              { return __hip_atomic_load(p, __ATOMIC_RELAXED, __HIP_MEMORY_SCOPE_AGENT); }
__device__ __forceinline__ unsigned xb_add(unsigned* p, unsigned v) { return __hip_atomic_fetch_add(p, v, __ATOMIC_RELAXED, __HIP_MEMORY_SCOPE_AGENT); }
__device__ __forceinline__ unsigned xb_xcc_id() { return (unsigned)__builtin_amdgcn_s_getreg((3 << 11) | 20) & 0xFu; }
#define XB_SPIN(cond, bar) do { unsigned _sp = 0; while (cond) { __builtin_amdgcn_s_sleep(1); \
    if ((++_sp & 255u) == 0u) { if (xb_ld(&(bar)[XB_TMO])) break; if (_sp > XB_SPIN_CAP) { atomicAdd(&(bar)[XB_TMO], 1u); break; } } } } while (0)

struct XcdBarrier {
    unsigned* bar; unsigned x;
    volatile LAS unsigned* st;
};

__device__ __forceinline__ XcdBarrier xcd_barrier_post(unsigned* bar, volatile LAS unsigned* st) {
    XcdBarrier b; b.bar = bar; b.x = xb_xcc_id(); b.st = st;
    if (threadIdx.x == 0) (void)xb_add(&bar[XB_XCNT(b.x)], 1u);
    return b;
}
__device__ __forceinline__ void xcd_barrier_complete(unsigned* bar, unsigned x, unsigned& nloc, unsigned& nx) {
    const unsigned G = gridDim.x * gridDim.y * gridDim.z;
    unsigned sum, cnt, mine, sp = 0u;
    for (;;) {
        sum = 0u; cnt = 0u; mine = 0u;
#pragma unroll
        for (unsigned j = 0; j < 16; ++j) { const unsigned c = xb_ld(&bar[XB_XCNT(j)]); sum += c; cnt += (c > 0u) ? 1u : 0u; mine = (j == x) ? c : mine; }
        if (sum == G) break;
        __builtin_amdgcn_s_sleep(1);
        if ((++sp & 255u) == 0u) { if (xb_ld(&bar[XB_TMO])) break; if (sp > XB_SPIN_CAP) { atomicAdd(&bar[XB_TMO], 1u); break; } }
    }
    nloc = mine > 0u ? mine : 1u; nx = cnt > 0u ? cnt : 1u;
}

__device__ __forceinline__ void xcd_barrier(const XcdBarrier& b) {
    asm volatile("s_waitcnt vmcnt(0)" ::: "memory");
    __syncthreads();
    if (threadIdx.x == 0) {
        unsigned* bar = b.bar;
        __builtin_amdgcn_s_waitcnt(0);
        unsigned nloc = b.st[0], nx = b.st[1];
        if (nloc == 0u) { xcd_barrier_complete(bar, b.x, nloc, nx); b.st[0] = nloc; b.st[1] = nx; }
        const unsigned old = xb_add(&bar[XB_XSUB(b.x)], 1u);
        const unsigned gen = old / nloc;
        if (old + 1u == (gen + 1u) * nloc) {
            __builtin_amdgcn_fence(__ATOMIC_RELEASE, "agent");
            asm volatile("s_waitcnt vmcnt(0)" ::: "memory");
            const unsigned og = xb_add(&bar[XB_TOP], 1u);
            const unsigned tg = og / nx;
            if (og + 1u == (tg + 1u) * nx) xb_add(&bar[XB_TOPGEN], 1u);
            else XB_SPIN(xb_ld(&bar[XB_TOPGEN]) == tg, bar);
            __builtin_amdgcn_fence(__ATOMIC_ACQUIRE, "agent");
            xb_add(&bar[XB_XGEN(b.x)], 1u);
            asm volatile("s_waitcnt vmcnt(0)" ::: "memory");
        } else {
            XB_SPIN(xb_ld(&bar[XB_XGEN(b.x)]) == gen, bar);
            __builtin_amdgcn_fence(__ATOMIC_ACQUIRE, "agent");
            asm volatile("s_waitcnt vmcnt(0)" ::: "memory");
        }
    }
    __syncthreads();
}


struct Args { const float* in[11]; float* out; unsigned char* ws; int ph_lo, ph_hi, coop, pad; };

__device__ __forceinline__ float wave_sum(float v) {
#pragma unroll
    for (int o = 1; o < 64; o <<= 1) v += __shfl_xor(v, o);
    return v;
}
__device__ __forceinline__ void p0_transpose_item(const float* W, int K, int N, u16* WT, LAS float* scr, int item, int lane) {
    const int nblk = N / 32, kb = item / nblk, nb = item % nblk, k0 = 64 * kb, n0 = 32 * nb;
#pragma unroll 8
    for (int i = 0; i < 32; ++i) { const int kk = 2 * i + (lane >> 5); scr[kk * 33 + (lane & 31)] = W[(size_t)(k0 + kk) * N + n0 + (lane & 31)]; }
    LDS_WAIT(); asm volatile("" ::: "memory");
    const int c = lane & 7;
#pragma unroll
    for (int j = 0; j < 4; ++j) { const int n = (lane >> 3) + 8 * j; const LAS float* s = scr + (8 * c) * 33 + n;
        v4u o; o.x = pk2(s[0 * 33], s[1 * 33]); o.y = pk2(s[2 * 33], s[3 * 33]); o.z = pk2(s[4 * 33], s[5 * 33]); o.w = pk2(s[6 * 33], s[7 * 33]);
        *(v4u*)(WT + (size_t)(n0 + n) * K + k0 + 8 * c) = o; }
    LDS_WAIT(); asm volatile("" ::: "memory");
}
__device__ __forceinline__ void p0_prologue(const Args& a, LAS unsigned char* lds, int gw, int NGW, int wave, int lane) {
    unsigned char* ws = a.ws;
    LAS float* scr = (LAS float*)(lds + wave * 16384);
    constexpr int I0 = (DM / 64) * (N0 / 32), I1 = (DM / 64) * (DM / 32), I2 = (DM / 64) * (N1 / 32), I3 = I1, NITEMS = I0 + I1 + I2 + I3;
    for (int it = gw; it < NITEMS; it += NGW) {
        int r = it;
        if (r < I0) { p0_transpose_item(a.in[2], DM, N0, (u16*)(ws + WS_W0IN), scr, r, lane); continue; } r -= I0;
        if (r < I1) { p0_transpose_item(a.in[4], DM, DM, (u16*)(ws + WS_W0OUT), scr, r, lane); continue; } r -= I1;
        if (r < I2) { p0_transpose_item(a.in[6], DM, N1, (u16*)(ws + WS_W1IN), scr, r, lane); continue; } r -= I2;
        p0_transpose_item(a.in[9], DM, DM, (u16*)(ws + WS_W1OUT), scr, r, lane);
    }
    const float* x = a.in[0]; const float* g0 = a.in[1]; u16* XN = (u16*)(ws + WS_XN);
    f32x4 gv[4];
#pragma unroll
    for (int j = 0; j < 4; ++j) gv[j] = ((const f32x4*)g0)[lane + 64 * j];
    for (int m = gw; m < M; m += NGW) {
        const f32x4* xr = (const f32x4*)(x + (size_t)m * DM) + lane; f32x4 v[4]; float s = 0.f;
#pragma unroll
        for (int j = 0; j < 4; ++j) { v[j] = xr[64 * j]; s += (v[j][0] * v[j][0] + v[j][1] * v[j][1]) + (v[j][2] * v[j][2] + v[j][3] * v[j][3]); }
        const float r = 1.0f / sqrtf(wave_sum(s) * (1.0f / DM) + EPS);
        unsigned long long* o8 = (unsigned long long*)(XN + (size_t)m * DM) + lane;
#pragma unroll
        for (int j = 0; j < 4; ++j) { const f32x4 y = v[j] * r * gv[j]; o8[64 * j] = (unsigned long long)pk2(y[0], y[1]) | ((unsigned long long)pk2(y[2], y[3]) << 32); }
    }
    const int gt = gw * 64 + lane, NGT = NGW * 64;
    u16* TFC = (u16*)(ws + WS_TFC); u16* T128 = (u16*)(ws + WS_T128); u16* T64 = (u16*)(ws + WS_T64); f32x2* TTW = (f32x2*)(ws + WS_TTW); f32x2* TROPE = (f32x2*)(ws + WS_TROPE);
    for (int i = gt; i < 32768; i += NGT) {
        const int e = i & 7, ln = (i >> 3) & 63, j = (i >> 9) & 7, cb = i >> 12, lp = 32 * cb + (ln & 31), c = 16 * j + 8 * (ln >> 5) + e;
        const int l = lp & 127, ph = (l * c) & 127; const float xx = (float)ph * (1.0f / 64.0f);
        TFC[i] = f2h(lp < 128 ? cospif(xx) : -sinpif(xx));
    }
    for (int i = gt; i < 32768; i += NGT) {
        const int e = i & 7, ln = (i >> 3) & 63, j = (i >> 9) & 3, vt = (i >> 11) & 3, rt = i >> 13, k2 = 32 * rt + (ln & 31), s2 = 64 * (vt & 1) + 16 * j + 8 * (ln >> 5) + e;
        const int ph = (k2 * s2) & 127; const float xx = (float)ph * (1.0f / 64.0f);
        T128[i] = f2h((vt >> 1) ? sinpif(xx) : cospif(xx));
    }
    for (int i = gt; i < 12288; i += NGT) {
        const int e = i & 7, ln = (i >> 3) & 63, ch = (i >> 9) & 3, mt = (i >> 11) & 1, ty = i >> 12, k1 = 32 * mt + (ln & 31), s1 = 16 * ch + (e & 3) + 8 * (e >> 2) + 4 * (ln >> 5);
        const int ph = (k1 * s1) & 63; const float xx = (float)ph * (1.0f / 32.0f);
        T64[i] = f2h(ty == 0 ? cospif(xx) : (ty == 1 ? sinpif(xx) : -sinpif(xx)));
    }
    for (int i = gt; i < 8192; i += NGT) {
        const int k1 = i & 63, s2 = i >> 6; const float xx = (float)(k1 * s2) * (1.0f / 4096.0f);
        TTW[i] = (f32x2){cospif(xx), sinpif(xx)};
    }
    for (int i = gt; i < 4096; i += NGT) {
        const int j = i & 31, pos = i >> 5; const float inv = powf(10000.0f, -(float)j / 32.0f); const float ang = (float)pos * inv;
        TROPE[i] = (f32x2){cosf(ang), sinf(ang)};
    }
}

__device__ __forceinline__ void unpack8(const v4u w, float (&f)[8]) { f[0] = bflo(w.x); f[1] = bfhi(w.x); f[2] = bflo(w.y); f[3] = bfhi(w.y); f[4] = bflo(w.z); f[5] = bfhi(w.z); f[6] = bflo(w.w); f[7] = bfhi(w.w); }
__device__ __forceinline__ void p2_conv(const Args& a, int gtid, int ngt) {
    const u16* P = (const u16*)(a.ws + WS_PROJ); u16* Y = (u16*)(a.ws + WS_YCAT); const float* cw = a.in[3];
    for (int idx = gtid; idx < M * 64; idx += ngt) {
        const int t = idx >> 6, c8 = (idx & 63) * 8, s = t & (SEQ - 1);
        const u16* row = P + (size_t)t * N0 + c8;
        const v4u z4 = {0u, 0u, 0u, 0u};
        const v4u ax1 = *(const v4u*)(row), ab1 = *(const v4u*)(row + 512), ac1 = *(const v4u*)(row + 1024), az1 = *(const v4u*)(row + 1536);
        const v4u ax0 = s > 0 ? *(const v4u*)(row - N0) : z4, ac0 = s > 0 ? *(const v4u*)(row - N0 + 1024) : z4;
        const v4u ax2 = s < SEQ - 1 ? *(const v4u*)(row + N0) : z4, ac2 = s < SEQ - 1 ? *(const v4u*)(row + N0 + 1024) : z4;
        float w0[8], w1[8], w2[8];
        { const f32x4 q0 = *(const f32x4*)(cw + c8), q1 = *(const f32x4*)(cw + c8 + 4); for (int i = 0; i < 4; ++i) { w0[i] = q0[i]; w0[4 + i] = q1[i]; } }
        { const f32x4 q0 = *(const f32x4*)(cw + 512 + c8), q1 = *(const f32x4*)(cw + 512 + c8 + 4); for (int i = 0; i < 4; ++i) { w1[i] = q0[i]; w1[4 + i] = q1[i]; } }
        { const f32x4 q0 = *(const f32x4*)(cw + 1024 + c8), q1 = *(const f32x4*)(cw + 1024 + c8 + 4); for (int i = 0; i < 4; ++i) { w2[i] = q0[i]; w2[4 + i] = q1[i]; } }
        float x0[8], x1[8], x2[8], c0[8], c1[8], c2[8], bb[8], zz[8], y[8];
        unpack8(ax0, x0); unpack8(ax1, x1); unpack8(ax2, x2); unpack8(ac0, c0); unpack8(ac1, c1); unpack8(ac2, c2); unpack8(ab1, bb); unpack8(az1, zz);
#pragma unroll
        for (int i = 0; i < 8; ++i) { const float cv = (c0[i] * x0[i]) * w0[i] + (c1[i] * x1[i]) * w1[i] + (c2[i] * x2[i]) * w2[i]; y[i] = bb[i] * cv * silu(zz[i]); }
        v4u o; o.x = pk2(y[0], y[1]); o.y = pk2(y[2], y[3]); o.z = pk2(y[4], y[5]); o.w = pk2(y[6], y[7]);
        *(v4u*)(Y + (size_t)t * DM + c8) = o;
    }
}

#define MFMA16(a, b, c) __builtin_amdgcn_mfma_f32_32x32x16_f16(__builtin_bit_cast(f16x8, a), __builtin_bit_cast(f16x8, b), (c), 0, 0, 0)
__device__ __forceinline__ s16x8 pack8h(const f32x16& x, int s) {
    v4u p;
    p.x = (unsigned)f2h(x[8 * s + 0]) | ((unsigned)f2h(x[8 * s + 1]) << 16); p.y = (unsigned)f2h(x[8 * s + 2]) | ((unsigned)f2h(x[8 * s + 3]) << 16);
    p.z = (unsigned)f2h(x[8 * s + 4]) | ((unsigned)f2h(x[8 * s + 5]) << 16); p.w = (unsigned)f2h(x[8 * s + 6]) | ((unsigned)f2h(x[8 * s + 7]) << 16);
    return __builtin_bit_cast(s16x8, p);
}
__device__ __forceinline__ void p2_fft1(const Args& a, int G, int wave, int lane) {
    const u16* P = (const u16*)(a.ws + WS_PROJ); u16* AB = (u16*)(a.ws + WS_ABUF);
    const s16x8* TFC = (const s16x8*)(a.ws + WS_TFC); const s16x8* T64 = (const s16x8*)(a.ws + WS_T64); const f32x2* TTW = (const f32x2*)(a.ws + WS_TTW);
    const int q = wave & 3, m = lane & 31, h = lane >> 5;
    for (int it = (int)blockIdx.x * 2 + (wave >> 2); it < 1024; it += 2 * G) {
        const int b = it >> 9, s2 = (it >> 2) & 127, g = it & 3;
        const u16* ub = P + ((size_t)(b * SEQ + s2 + 128 * m)) * N0 + 2048 + g * 128 + 8 * h;
        f32x16 Tr0 = {}, Tr1 = {}, Ti0 = {}, Ti1 = {};
#pragma unroll
        for (int j = 0; j < 8; ++j) {
            const s16x8 a0 = *(const s16x8*)(ub + 16 * j), a1 = *(const s16x8*)(ub + (size_t)32 * 128 * N0 + 16 * j);
            const s16x8 br = TFC[(q * 8 + j) * 64 + lane], bi = TFC[((4 + q) * 8 + j) * 64 + lane];
            Tr0 = MFMA16(a0, br, Tr0); Tr1 = MFMA16(a1, br, Tr1); Ti0 = MFMA16(a0, bi, Ti0); Ti1 = MFMA16(a1, bi, Ti1);
        }
        s16x8 Btr[4], Bti[4];
        Btr[0] = pack8h(Tr0, 0); Btr[1] = pack8h(Tr0, 1); Btr[2] = pack8h(Tr1, 0); Btr[3] = pack8h(Tr1, 1);
        Bti[0] = pack8h(Ti0, 0); Bti[1] = pack8h(Ti0, 1); Bti[2] = pack8h(Ti1, 0); Bti[3] = pack8h(Ti1, 1);
#pragma unroll
        for (int mt = 0; mt < 2; ++mt) {
            f32x16 Dr = {}, Di = {};
#pragma unroll
            for (int ch = 0; ch < 4; ++ch) {
                const s16x8 C = T64[((0 * 2 + mt) * 4 + ch) * 64 + lane], S = T64[((1 * 2 + mt) * 4 + ch) * 64 + lane], nS = T64[((2 * 2 + mt) * 4 + ch) * 64 + lane];
                Dr = MFMA16(C, Btr[ch], Dr); Dr = MFMA16(S, Bti[ch], Dr); Di = MFMA16(C, Bti[ch], Di); Di = MFMA16(nS, Btr[ch], Di);
            }
#pragma unroll
            for (int r = 0; r < 16; ++r) {
                const int k1 = 32 * mt + crow(r, h); const f32x2 tw = TTW[s2 * 64 + k1];
                const float ar = Dr[r] * tw[0] + Di[r] * tw[1], ai = Di[r] * tw[0] - Dr[r] * tw[1];
                u16* dst = AB + ((((size_t)(b * 64 + k1) * 4 + g) * 2) * 128 + s2) * 128 + 32 * q + m;
                dst[0] = f2h(ar); dst[128 * 128] = f2h(ai);
            }
        }
    }
}

__device__ __forceinline__ void p3_fft2(const Args& a, unsigned char* lds, int G, int tid, int wave, int lane) {
    const u16* AB = (const u16*)(a.ws + WS_ABUF); const u16* P = (const u16*)(a.ws + WS_PROJ); u16* Y = (u16*)(a.ws + WS_YCAT);
    const s16x8* T128 = (const s16x8*)(a.ws + WS_T128);
    const int sr = tid >> 4, sc = (tid & 15) * 8, vst0 = att::v_st(sr, sc), vst1 = att::v_st(32 + sr, sc);
    const int rt = wave & 3, cbp = wave >> 2, r32 = lane & 31, hi = lane >> 5;
    const int vb = (int)(uintptr_t)lds + att::v_rd_base(lane) + (2 * cbp) * 512;
    for (int it = (int)blockIdx.x; it < 512; it += G) {
        const int b = it >> 8, k1 = (it >> 2) & 63, g = it & 3;
        const u16* src = AB + (size_t)it * 32768;
        s16x8 st[8];
#pragma unroll
        for (int vt = 0; vt < 4; ++vt) { st[2 * vt] = *(const s16x8*)(src + vt * 8192 + sr * 128 + sc); st[2 * vt + 1] = *(const s16x8*)(src + vt * 8192 + (32 + sr) * 128 + sc); }
#pragma unroll
        for (int vt = 0; vt < 4; ++vt) { *(s16x8*)(lds + vt * 16384 + vst0) = st[2 * vt]; *(s16x8*)(lds + vt * 16384 + vst1) = st[2 * vt + 1]; }
        __syncthreads();
        f32x16 od0 = {}, od1 = {};
#pragma unroll
        for (int vt = 0; vt < 4; ++vt) {
            const s16x8* tp = T128 + ((rt * 4 + vt) * 4) * 64 + lane;
            const s16x8 pa0 = tp[0], pa1 = tp[64], pa2 = tp[128], pa3 = tp[192];
            att::pv_one_f16(od0, vb + vt * 16384, pa0, pa1, pa2, pa3);
            att::pv_one_f16(od1, vb + vt * 16384 + 512, pa0, pa1, pa2, pa3);
        }
#pragma unroll
        for (int dd = 0; dd < 2; ++dd)
#pragma unroll
            for (int r = 0; r < 16; ++r) {
                const int k = k1 + 64 * (32 * rt + crow(r, hi)), l = 32 * (2 * cbp + dd) + r32; const size_t tok = (size_t)b * SEQ + k;
                const float z = bflo((unsigned)P[tok * N0 + 2560 + g * 128 + l]);
                const float f = (dd ? od1[r] : od0[r]) * (1.0f / 1024.0f);
                Y[tok * DM + 512 + g * 128 + l] = (u16)f2bf(f * silu(z));
            }
        __syncthreads();
    }
}

__device__ __forceinline__ void p6_qknorm(const Args& a, int gtid, int ngt) {
    u16* P = (u16*)(a.ws + WS_PROJ); const f32x2* TR = (const f32x2*)(a.ws + WS_TROPE); const float* qg = a.in[7]; const float* kg = a.in[8];
    for (int idx = gtid; idx < M * 10 * 16; idx += ngt) {
        const int li = idx & 15, th = idx >> 4, hh = th % 10, t = th / 10, s = t & (SEQ - 1);
        u16* p = P + (size_t)t * N1 + (hh < 8 ? hh * 128 : 1024 + (hh - 8) * 128) + 8 * li;
        const float* gn = (hh < 8 ? qg : kg) + 8 * li;
        float v[8]; unpack8(*(const v4u*)p, v);
        float ss = 0.f;
#pragma unroll
        for (int i = 0; i < 8; ++i) ss += v[i] * v[i];
        ss += __shfl_xor(ss, 1); ss += __shfl_xor(ss, 2); ss += __shfl_xor(ss, 4); ss += __shfl_xor(ss, 8);
        const float r = 1.0f / sqrtf(ss * (1.0f / 128.0f) + EPS);
        const f32x4 g0 = *(const f32x4*)gn, g1 = *(const f32x4*)(gn + 4);
#pragma unroll
        for (int i = 0; i < 4; ++i) { v[i] = v[i] * r * g0[i]; v[4 + i] = v[4 + i] * r * g1[i]; }
        float o[8];
#pragma unroll
        for (int i = 0; i < 4; ++i) { const int pr = 4 * li + i; const f32x2 cs = pr < 32 ? TR[(s >> 6) * 32 + pr] : TR[(s & 63) * 32 + pr - 32];
            o[2 * i] = v[2 * i] * cs[0] - v[2 * i + 1] * cs[1]; o[2 * i + 1] = v[2 * i] * cs[1] + v[2 * i + 1] * cs[0]; }
        v4u w; w.x = pk2(o[0], o[1]); w.y = pk2(o[2], o[3]); w.z = pk2(o[4], o[5]); w.w = pk2(o[6], o[7]);
        *(v4u*)p = w;
    }
}

__device__ __forceinline__ void p9_final(const Args& a, int gw, int NGW, int lane) {
    float* out = a.out; const float* gf = a.in[10];
    f32x4 gv[4];
#pragma unroll
    for (int j = 0; j < 4; ++j) gv[j] = ((const f32x4*)gf)[lane + 64 * j];
    for (int m = gw; m < M; m += NGW) {
        f32x4* xr = (f32x4*)(out + (size_t)m * DM) + lane; f32x4 v[4]; float s = 0.f;
#pragma unroll
        for (int j = 0; j < 4; ++j) { v[j] = xr[64 * j]; s += (v[j][0] * v[j][0] + v[j][1] * v[j][1]) + (v[j][2] * v[j][2] + v[j][3] * v[j][3]); }
        const float r = 1.0f / sqrtf(wave_sum(s) * (1.0f / DM) + EPS);
#pragma unroll
        for (int j = 0; j < 4; ++j) xr[64 * j] = v[j] * r * gv[j];
    }
}

#ifndef MK_PG8_ALIGN
#define MK_PG8_ALIGN true
#endif
#ifndef MK_PG8_SP2
#define MK_PG8_SP2 true
#endif
__global__ void __launch_bounds__(NTHR, 2) enc_fwd(Args args) {
    extern __shared__ __attribute__((aligned(16))) unsigned char lds_raw[];
    LAS unsigned char* lds = (LAS unsigned char*)lds_raw;
    const int tid = threadIdx.x, lane = tid & 63, wave = __builtin_amdgcn_readfirstlane(tid >> 6);
    const int G = gridDim.x, bid = blockIdx.x;
    const int gw = bid * NWAVES + wave, NGW = G * NWAVES, gtid = bid * NTHR + tid, ngt = G * NTHR;
    unsigned char* ws = args.ws;
    volatile LAS unsigned* MISC = (volatile LAS unsigned*)(lds + MISC_OFF);
    for (int u = tid; u < (LDS_BYTES - RING_BYTES) / 4; u += NTHR) ((LAS unsigned*)(lds + RING_BYTES))[u] = 0u;
    __syncthreads();
    const int lo = args.ph_lo, hi = args.ph_hi;
    const bool multi = (hi - lo) > 1;
    XcdBarrier bar; bar.bar = (unsigned*)(ws + WS_CTL) + CW_BAR; bar.x = 0; bar.st = nullptr;
    if (multi && args.coop == 1) bar = xcd_barrier_post((unsigned*)(ws + WS_CTL) + CW_BAR, MISC + 8);
#define IN(k) (lo <= (k) && (k) < hi)
#define SEAM(k) do { if (IN(k) && IN((k) + 1)) { if (args.coop == 2) cg::this_grid().sync(); else xcd_barrier(bar); } } while (0)

    if (IN(0)) { p0_prologue(args, lds, gw, NGW, wave, lane); }
    SEAM(0);
    if (IN(1)) {
        pg8::Gemm g{(const pg8::bf16_t*)(ws + WS_XN), (const pg8::bf16_t*)(ws + WS_W0IN), M, N0, DM}; pg8::StaticOrder S; S.init(M, N0, G, bid);
        pg8::EpiScale E{(pg8::bf16_t*)(ws + WS_PROJ), N0, nullptr, 2048, 2560, EPS};
        pg8::gemm_phase<pg8::EpiScale, pg8::StaticOrder, MK_PG8_ALIGN, MK_PG8_SP2>(lds, g, S, E);
    }
    SEAM(1);
    if (IN(2)) { p2_fft1(args, G, wave, lane); p2_conv(args, gtid, ngt); }
    SEAM(2);
    if (IN(3)) { p3_fft2(args, lds_raw, G, tid, wave, lane); }
    SEAM(3);
    if (IN(4)) {
        pg8::Gemm g{(const pg8::bf16_t*)(ws + WS_YCAT), (const pg8::bf16_t*)(ws + WS_W0OUT), M, DM, DM}; pg8::StaticOrder S; S.init(M, DM, G, bid);
        pg8::EpiResid E{args.in[0], args.out, (pg8::bf16_t*)(ws + WS_XN), args.in[5], (float*)(ws + WS_SSP), DM};
        pg8::gemm_phase<pg8::EpiResid, pg8::StaticOrder, MK_PG8_ALIGN, MK_PG8_SP2>(lds, g, S, E);
    }
    SEAM(4);
    if (IN(5)) {
        pg8::Gemm g{(const pg8::bf16_t*)(ws + WS_XN), (const pg8::bf16_t*)(ws + WS_W1IN), M, N1, DM}; pg8::StaticOrder S; S.init(M, N1, G, bid);
        pg8::EpiScale E{(pg8::bf16_t*)(ws + WS_PROJ), N1, (const float*)(ws + WS_SSP), -1, -1, EPS};
        pg8::gemm_phase<pg8::EpiScale, pg8::StaticOrder, MK_PG8_ALIGN, MK_PG8_SP2>(lds, g, S, E);
    }
    SEAM(5);
    if (IN(6)) { p6_qknorm(args, gtid, ngt); }
    SEAM(6);
    if (IN(7)) {
        const att::bf16* P = (const att::bf16*)(ws + WS_PROJ); att::bf16* O = (att::bf16*)(ws + WS_YCAT);
        for (int i = bid; i < 512; i += G) {
            const int b = i >> 8, r = i & 255, x = r & 7, qb = r >> 3, h = 4 * (x & 1) + (x >> 1), kvh = h >> 2;
            const size_t row0 = (size_t)b * SEQ + (size_t)qb * 256;
            att::attn_dense_body(P + row0 * N1 + h * 128, P + (size_t)b * SEQ * N1 + 1024 + kvh * 128, P + (size_t)b * SEQ * N1 + 1280 + kvh * 128,
                                 P + row0 * N1 + 1536 + h * 128, O + row0 * DM + h * 128, SEQ, (char*)lds_raw);
            __syncthreads();
        }
    }
    SEAM(7);
    if (IN(8)) {
        pg8::Gemm g{(const pg8::bf16_t*)(ws + WS_YCAT), (const pg8::bf16_t*)(ws + WS_W1OUT), M, DM, DM}; pg8::StaticOrder S; S.init(M, DM, G, bid);
        pg8::EpiResid E{args.out, args.out, nullptr, nullptr, nullptr, DM};
        pg8::gemm_phase<pg8::EpiResid, pg8::StaticOrder, MK_PG8_ALIGN, MK_PG8_SP2>(lds, g, S, E);
    }
    SEAM(8);
    if (IN(9)) { p9_final(args, gw, NGW, lane); }
#undef IN
#undef SEAM
}

#ifndef MK_ONE_LAUNCH
#define MK_ONE_LAUNCH 0
#endif
extern "C" void kernel_launch(void* const* d_in, const int* in_sizes, int n_in, void* d_out, int out_size, void* d_ws, size_t ws_size, hipStream_t stream) {
    static int grid = 0;
    if (grid == 0) {
        if (n_in != 11 || in_sizes[0] != M * DM || out_size != M * DM || ws_size < WS_END) { fprintf(stderr, "kernel_launch: shape mismatch (n_in %d, in0 %d, out %d, ws %zu)\n", n_in, n_in > 0 ? in_sizes[0] : -1, out_size, ws_size); grid = -1; return; }
        int dev = 0, cus = 0, per_cu = 0;
        if (hipGetDevice(&dev) != hipSuccess || hipDeviceGetAttribute(&cus, hipDeviceAttributeMultiprocessorCount, dev) != hipSuccess) { grid = -1; return; }
        if (hipFuncSetAttribute((const void*)enc_fwd, hipFuncAttributeMaxDynamicSharedMemorySize, LDS_BYTES) != hipSuccess) { fprintf(stderr, "kernel_launch: hipFuncSetAttribute failed\n"); grid = -1; return; }
        if (hipOccupancyMaxActiveBlocksPerMultiprocessor(&per_cu, (const void*)enc_fwd, NTHR, LDS_BYTES) != hipSuccess || per_cu < 1) { fprintf(stderr, "kernel_launch: occupancy query says %d\n", per_cu); per_cu = 1; }
        (void)hipGetLastError();
        grid = cus * per_cu;
    }
    if (grid < 0) return;
    Args a{};
    for (int i = 0; i < 11; ++i) a.in[i] = (const float*)d_in[i];
    a.out = (float*)d_out; a.ws = (unsigned char*)d_ws;
#if MK_ONE_LAUNCH
    if (hipMemsetAsync((char*)d_ws + WS_CTL, 0, CTL_ZERO_BYTES, stream) != hipSuccess) { fprintf(stderr, "kernel_launch: memset failed\n"); return; }
    a.ph_lo = 0; a.ph_hi = 10; a.coop = MK_ONE_LAUNCH;
    void* kargs[] = {&a};
    const hipError_t e = hipLaunchCooperativeKernel((const void*)enc_fwd, dim3(grid), dim3(NTHR), kargs, LDS_BYTES, stream);
    if (e != hipSuccess) fprintf(stderr, "kernel_launch: cooperative launch failed: %s (grid %d)\n", hipGetErrorString(e), grid);
#else
    for (int p = 0; p < 10; ++p) {
        a.ph_lo = p; a.ph_hi = p + 1; a.coop = 0;
        hipLaunchKernelGGL(enc_fwd, dim3(grid), dim3(NTHR), LDS_BYTES, stream, a);
    }
    const hipError_t le = hipPeekAtLastError();
    if (le != hipSuccess) fprintf(stderr, "kernel_launch: launch failed: %s\n", hipGetErrorName(le));
#endif
}
```

```cpp
#include <hip/hip_runtime.h>
#include <hip/hip_cooperative_groups.h>
#include <hip/hip_bf16.h>
#include <cstdio>
#include <cstdint>
#include <cmath>
#define MK_ONE_LAUNCH 1
namespace pg8 {
#define PG8_LAS __attribute__((address_space(3)))
typedef unsigned short bf16_t;
typedef short bf16x8 __attribute__((ext_vector_type(8)));
typedef float f32x4 __attribute__((ext_vector_type(4)));
typedef unsigned u32x4 __attribute__((ext_vector_type(4)));
constexpr int BM = 256, BK = 64, HALF = 128, HTB = HALF * BK * 2  , STAGE_BYTES = 8 * HTB, NXCD = 8, WGM = 8;

__host__ __device__ __forceinline__ int lds_byte(int r, int c) { const int st = (r >> 4) * 2 + (c >> 5), rr = r & 15, cc = c & 31, ob = rr * 64 + cc * 2; return st * 1024 + (ob ^ (((ob >> 9) & 1) << 5)); }
__host__ __device__ __forceinline__ void stage_rc(int b, int& R, int& C) { const int st = b / 1024, sb = b % 1024, swz = sb ^ (((sb >> 9) & 1) << 5); R = (st >> 1) * 16 + swz / 64; C = (st & 1) * 32 + (swz % 64) / 2; }
__host__ __device__ __forceinline__ int perm32(int rho) { const int n = rho >> 4, i = rho & 15; return 8 * (i >> 2) + 4 * n + (i & 3); }

struct Unit { int pm, pn; };
struct Gemm { const bf16_t* A; const bf16_t* Bt; int M, N, K; };

struct StaticOrder {
    int nM, nN, nwg, G, c;
    __host__ __device__ void init(int M, int N, int G_, int c_) { nM = M / BM; nN = N / BM; nwg = nM * nN; G = G_; c = c_; }
    __host__ __device__ bool next(int i, Unit& u) const {
        const long L = (long)i * G + c; if (L >= nwg) return false;
        int wgid = (int)L; { const int q = nwg / NXCD, r = nwg % NXCD, xcd = wgid % NXCD, off = wgid / NXCD; wgid = (xcd < r ? xcd * (q + 1) : r * (q + 1) + (xcd - r) * q) + off; }
        const int nig = WGM * nN, gid = wgid / nig, fm = gid * WGM, gsz = (nM - fm) < WGM ? (nM - fm) : WGM;
        u.pm = fm + ((wgid % nig) % gsz); u.pn = (wgid % nig) / gsz; return true;
    }
    __device__ __forceinline__ void a_ready(const Unit&) const {}
    __device__ __forceinline__ void done(const Unit&) const {}
};

__device__ __forceinline__ unsigned cvt_pk_bf16(float lo, float hi) { unsigned r; asm volatile("v_cvt_pk_bf16_f32 %0, %1, %2" : "=v"(r) : "v"(lo), "v"(hi)); return r; }
__device__ __forceinline__ unsigned pk_f16(float lo, float hi) { const _Float16 a = (_Float16)lo, b = (_Float16)hi; return (unsigned)__builtin_bit_cast(unsigned short, a) | ((unsigned)__builtin_bit_cast(unsigned short, b) << 16); }
struct EpiScale {
    static constexpr bool PERM = true, AFTER_DRAIN = false;
    bf16_t* O; int ldc; const float* ssp; int f16_lo, f16_hi; float eps;
    __device__ __forceinline__ void operator()(const f32x4 (&acc)[2][2][4][2], const Unit& u, int wr, int wc, int fr, int fq) const {
        const int row0 = u.pm * BM + wr * 64 + fr, colt = u.pn * BM, col0 = colt + wc * 32 + 8 * fq;
        const bool h16 = (colt >= f16_lo) && (colt < f16_hi);
#pragma unroll
        for (int ai = 0; ai < 2; ++ai)
#pragma unroll
            for (int m = 0; m < 4; ++m) { const int row = row0 + ai * HALF + m * 16; float sc = 1.f;
                if (ssp) { const f32x4* sp = (const f32x4*)(ssp + (size_t)row * 16); const f32x4 a = sp[0], b = sp[1], c = sp[2], d = sp[3];
                    const float s = ((a[0] + a[1]) + (a[2] + a[3])) + ((b[0] + b[1]) + (b[2] + b[3])) + ((c[0] + c[1]) + (c[2] + c[3])) + ((d[0] + d[1]) + (d[2] + d[3]));
                    sc = 1.0f / sqrtf(s * (1.0f / 1024.0f) + eps); }
                bf16_t* rowp = O + (size_t)row * ldc + col0;
#pragma unroll
                for (int bj = 0; bj < 2; ++bj) { const f32x4 v0 = acc[ai][bj][m][0] * sc, v1 = acc[ai][bj][m][1] * sc; u32x4 w;
                    if (h16) { w.x = pk_f16(v0[0], v0[1]); w.y = pk_f16(v0[2], v0[3]); w.z = pk_f16(v1[0], v1[1]); w.w = pk_f16(v1[2], v1[3]); }
                    else { w.x = cvt_pk_bf16(v0[0], v0[1]); w.y = cvt_pk_bf16(v0[2], v0[3]); w.z = cvt_pk_bf16(v1[0], v1[1]); w.w = cvt_pk_bf16(v1[2], v1[3]); }
                    *(u32x4*)(rowp + bj * HALF) = w; } }
    }
};
struct EpiResid {
    static constexpr bool PERM = false, AFTER_DRAIN = false;
    const float* base; float* out; bf16_t* xg; const float* gain; float* ssp; int ldc;
    __device__ __forceinline__ void operator()(const f32x4 (&acc)[2][2][4][2], const Unit& u, int wr, int wc, int fr, int fq) const {
        typedef unsigned u32x2v __attribute__((ext_vector_type(2)));
        const int col0 = u.pn * BM + wc * 32 + 4 * fq;
#pragma unroll
        for (int ai = 0; ai < 2; ++ai)
#pragma unroll
            for (int m = 0; m < 4; ++m) { const int row = u.pm * BM + ai * HALF + wr * 64 + m * 16 + fr; const size_t off = (size_t)row * ldc + col0; float s = 0.f;
#pragma unroll
                for (int bj = 0; bj < 2; ++bj)
#pragma unroll
                    for (int n = 0; n < 2; ++n) { const int co = bj * HALF + n * 16; const f32x4 bs = *(const f32x4*)(base + off + co); const f32x4 o = bs + acc[ai][bj][m][n];
                        *(f32x4*)(out + off + co) = o; s += (o[0] * o[0] + o[1] * o[1]) + (o[2] * o[2] + o[3] * o[3]);
                        if (xg) { const f32x4 g = *(const f32x4*)(gain + col0 + co); u32x2v w; w.x = cvt_pk_bf16(o[0] * g[0], o[1] * g[1]); w.y = cvt_pk_bf16(o[2] * g[2], o[3] * g[3]); *(u32x2v*)(xg + off + co) = w; } }
                if (ssp) { s += __shfl_xor(s, 16); s += __shfl_xor(s, 32); if (fq == 0) ssp[(size_t)row * 16 + u.pn * 4 + wc] = s; } }
    }
};

template <class Epi, class Sched, bool ALIGN_EPI = false, bool SP2 = false>
__device__ __forceinline__ void gemm_phase(PG8_LAS unsigned char* lds, const Gemm g, const Sched& S, const Epi& E) {
    const int tid = threadIdx.x, wid = __builtin_amdgcn_readfirstlane(tid >> 6), lane = tid & 63, wr = wid >> 2, wc = wid & 3, fr = lane & 15, fq = lane >> 4;
    const int K = g.K, nt = K / BK;
    unsigned voffA[2], voffB[2];
#pragma unroll
    for (int i = 0; i < 2; ++i) { int R, C; stage_rc(tid * 16 + i * 8192, R, C); const int Rb = Epi::PERM ? ((R & ~31) + perm32(R & 31)) : R;
        voffA[i] = (unsigned)(R * K + C) * 2u; voffB[i] = (unsigned)(Rb * K + C) * 2u; }
    const size_t kstep = (size_t)(BK * 2);
    const size_t hstep = (size_t)HALF * K * 2;
    const size_t tstep = 2 * hstep;
    const unsigned ldsw = (unsigned)wid * 1024u;
    const int aoff = lds_byte(wr * 64 + fr, fq * 8), boff = lds_byte(wc * 32 + fr, fq * 8);
#define PG8_SA(b, h) (((b) * 2 + (h)) * HTB)
#define PG8_SB(b, h) ((4 + (b) * 2 + (h)) * HTB)
#define PG8_STAGE(bufoff, gbase, voff) do { _Pragma("unroll") for (int _i = 0; _i < 2; ++_i) \
        __builtin_amdgcn_global_load_lds((const unsigned*)((const char*)(gbase) + (voff)[_i]), (PG8_LAS unsigned*)(lds + (bufoff) + ldsw + _i * 8192), 16, 0, 0); } while (0)
#define PG8_LDA(dst, b, h) do { _Pragma("unroll") for (int m = 0; m < 4; ++m) _Pragma("unroll") for (int k = 0; k < 2; ++k) dst[m][k] = *(const PG8_LAS bf16x8*)(lds + PG8_SA(b, h) + aoff + m * 2048 + k * 1024); } while (0)
#define PG8_LDB(dst, b, h) do { _Pragma("unroll") for (int n = 0; n < 2; ++n) _Pragma("unroll") for (int k = 0; k < 2; ++k) dst[n][k] = *(const PG8_LAS bf16x8*)(lds + PG8_SB(b, h) + boff + n * 2048 + k * 1024); } while (0)
#define PG8_MMA(ai, bj, At, Bt) do { __builtin_amdgcn_s_setprio(1); _Pragma("unroll") for (int m = 0; m < 4; ++m) _Pragma("unroll") for (int n = 0; n < 2; ++n) _Pragma("unroll") for (int k = 0; k < 2; ++k) \
        acc[ai][bj][m][n] = __builtin_amdgcn_mfma_f32_16x16x32_bf16(Bt[n][k], At[m][k], acc[ai][bj][m][n], 0, 0, 0); __builtin_amdgcn_s_setprio(0); } while (0)
#define PG8_WAIT_V(n) asm volatile("s_waitcnt vmcnt(" #n ")" ::: "memory")
#define PG8_WAIT_L(n) asm volatile("s_waitcnt lgkmcnt(" #n ")" ::: "memory")
#define PG8_BAR __builtin_amdgcn_s_barrier()
#define PG8_SCHED __builtin_amdgcn_sched_barrier(0)
    Unit cur, nxt; int ui = 0;
    if (!S.next(0, cur)) return;
    f32x4 acc[2][2][4][2];
#pragma unroll
    for (int a = 0; a < 2; ++a)
#pragma unroll
        for (int b = 0; b < 2; ++b)
#pragma unroll
            for (int m = 0; m < 4; ++m)
#pragma unroll
                for (int n = 0; n < 2; ++n) acc[a][b][m][n] = (f32x4){0.f, 0.f, 0.f, 0.f};
    bf16x8 At[4][2], B0[2][2], B1[2][2];
    const char* cA = (const char*)g.A + (size_t)cur.pm * tstep; const char* cB = (const char*)g.Bt + (size_t)cur.pn * tstep;
    S.a_ready(cur);
    if constexpr (SP2) {
        PG8_STAGE(PG8_SB(0, 0), cB, voffB); PG8_STAGE(PG8_SB(0, 1), cB + hstep, voffB); PG8_STAGE(PG8_SA(0, 0), cA, voffA); PG8_STAGE(PG8_SA(0, 1), cA + hstep, voffA);
        if (wr == 1) PG8_BAR;
        PG8_WAIT_V(2); PG8_BAR;
        PG8_STAGE(PG8_SB(1, 0), cB + kstep, voffB); PG8_STAGE(PG8_SA(1, 0), cA + kstep, voffA); PG8_STAGE(PG8_SB(1, 1), cB + hstep + kstep, voffB);
        PG8_WAIT_V(6); PG8_BAR;
    } else {
        PG8_STAGE(PG8_SB(0, 0), cB, voffB); PG8_STAGE(PG8_SA(0, 0), cA, voffA); PG8_STAGE(PG8_SB(0, 1), cB + hstep, voffB); PG8_STAGE(PG8_SA(0, 1), cA + hstep, voffA);
        if (wr == 1) PG8_BAR;
        PG8_WAIT_V(4); PG8_BAR;
        PG8_STAGE(PG8_SB(1, 0), cB + kstep, voffB); PG8_STAGE(PG8_SA(1, 0), cA + kstep, voffA); PG8_STAGE(PG8_SB(1, 1), cB + hstep + kstep, voffB);
        PG8_WAIT_V(6); PG8_BAR;
    }
    for (;;) {
        const bool has_next = S.next(ui + 1, nxt);
        const char* nA = has_next ? (const char*)g.A + (size_t)nxt.pm * tstep : cA; const char* nB = has_next ? (const char*)g.Bt + (size_t)nxt.pn * tstep : cB;
        for (int t = 0; t < nt; t += 2) {
            const bool last = (t == nt - 2);
            const char* a1 = cA + (size_t)(t + 1) * kstep;
            const char* a2 = last ? nA : cA + (size_t)(t + 2) * kstep; const char* b2 = last ? nB : cB + (size_t)(t + 2) * kstep;
            const char* a3 = a2 + kstep; const char* b3 = b2 + kstep;
            if (last && has_next) S.a_ready(nxt);
            if constexpr (SP2) {
            PG8_LDB(B0, 0, 0); PG8_LDB(B1, 0, 1); PG8_SCHED; PG8_LDA(At, 0, 0); PG8_STAGE(PG8_SA(1, 1), a1 + hstep, voffA);
            PG8_WAIT_V(8); PG8_WAIT_L(0); PG8_BAR; PG8_MMA(0, 0, At, B0); PG8_MMA(0, 1, At, B1); PG8_BAR; PG8_SCHED;
            PG8_LDA(At, 0, 1); PG8_STAGE(PG8_SB(0, 0), b2, voffB); PG8_STAGE(PG8_SB(0, 1), b2 + hstep, voffB); PG8_STAGE(PG8_SA(0, 0), a2, voffA);
            PG8_WAIT_V(8); PG8_WAIT_L(0); PG8_BAR; PG8_MMA(1, 0, At, B0); PG8_MMA(1, 1, At, B1); PG8_BAR; PG8_SCHED;
            PG8_LDB(B0, 1, 0); PG8_LDB(B1, 1, 1); PG8_SCHED; PG8_LDA(At, 1, 0); PG8_STAGE(PG8_SA(0, 1), a2 + hstep, voffA);
            PG8_WAIT_V(8); PG8_WAIT_L(0); PG8_BAR; PG8_MMA(0, 0, At, B0); PG8_MMA(0, 1, At, B1); PG8_BAR; PG8_SCHED;
            PG8_LDA(At, 1, 1); PG8_STAGE(PG8_SB(1, 0), b3, voffB); PG8_STAGE(PG8_SB(1, 1), b3 + hstep, voffB); PG8_STAGE(PG8_SA(1, 0), a3, voffA);
            PG8_WAIT_V(8); PG8_WAIT_L(0); PG8_BAR; PG8_MMA(1, 0, At, B0); PG8_MMA(1, 1, At, B1); PG8_BAR; PG8_SCHED;
            } else {
            PG8_LDB(B0, 0, 0); PG8_SCHED; PG8_LDA(At, 0, 0); PG8_STAGE(PG8_SA(1, 1), a1 + hstep, voffA);
            PG8_WAIT_L(8); PG8_BAR; PG8_WAIT_L(0); PG8_MMA(0, 0, At, B0); PG8_BAR; PG8_SCHED;
            PG8_LDB(B1, 0, 1); PG8_STAGE(PG8_SB(0, 0), b2, voffB);
            PG8_BAR; PG8_WAIT_L(0); PG8_MMA(0, 1, At, B1); PG8_BAR;
            PG8_LDA(At, 0, 1); PG8_STAGE(PG8_SA(0, 0), a2, voffA);
            PG8_BAR; PG8_WAIT_L(0); PG8_MMA(1, 0, At, B0); PG8_BAR; PG8_SCHED;
            PG8_STAGE(PG8_SB(0, 1), b2 + hstep, voffB);
            PG8_WAIT_V(6); PG8_BAR; PG8_MMA(1, 1, At, B1); PG8_BAR;
            PG8_LDB(B0, 1, 0); PG8_SCHED; PG8_LDA(At, 1, 0); PG8_STAGE(PG8_SA(0, 1), a2 + hstep, voffA);
            PG8_WAIT_L(8); PG8_BAR; PG8_WAIT_L(0); PG8_MMA(0, 0, At, B0); PG8_BAR; PG8_SCHED;
            PG8_LDB(B1, 1, 1); PG8_STAGE(PG8_SB(1, 0), b3, voffB);
            PG8_BAR; PG8_WAIT_L(0); PG8_MMA(0, 1, At, B1); PG8_BAR;
            PG8_LDA(At, 1, 1); PG8_STAGE(PG8_SA(1, 0), a3, voffA);
            PG8_BAR; PG8_WAIT_L(0); PG8_MMA(1, 0, At, B0); PG8_BAR; PG8_SCHED;
            PG8_STAGE(PG8_SB(1, 1), b3 + hstep, voffB);
            PG8_WAIT_V(6); PG8_BAR; PG8_MMA(1, 1, At, B1); PG8_BAR;
            }
        }
        if constexpr (ALIGN_EPI) { if (wr == 0) PG8_BAR; }
        if constexpr (!Epi::AFTER_DRAIN) { E(acc, cur, wr, wc, fr, fq); S.done(cur); }
        if (!has_next) break;
#pragma unroll
        for (int a = 0; a < 2; ++a)
#pragma unroll
            for (int b = 0; b < 2; ++b)
#pragma unroll
                for (int m = 0; m < 4; ++m)
#pragma unroll
                    for (int n = 0; n < 2; ++n) acc[a][b][m][n] = (f32x4){0.f, 0.f, 0.f, 0.f};
        cur = nxt; cA = nA; cB = nB; ++ui;
        if constexpr (ALIGN_EPI) { if (wr == 1) PG8_BAR; }
    }
    PG8_WAIT_V(0);
    if constexpr (!ALIGN_EPI) { if (wr == 0) PG8_BAR; }
    PG8_BAR;
    if constexpr (Epi::AFTER_DRAIN) { E.fused(acc, cur, wr, wc, fr, fq, lds, wid, lane); S.done(cur); }
#undef PG8_SA
#undef PG8_SB
#undef PG8_STAGE
#undef PG8_LDA
#undef PG8_LDB
#undef PG8_MMA
#undef PG8_WAIT_V
#undef PG8_WAIT_L
#undef PG8_BAR
#undef PG8_SCHED
}
}

namespace att {
using bf16 = __hip_bfloat16;
constexpr int   D = 128, NW = 8, QBLK = 32, KVBLK = 64;
constexpr float SCALE = 0.088388347648318440f;
constexpr float THR = 8.f;
constexpr int SDEPTH = 2;
constexpr int LDQ = 2560, LDK = 2560, LDZ = 2560, LDO = 1024;
constexpr size_t SHM_V = KVBLK * D * 2, SHM_K = KVBLK * D * 2, SHM_ATTN = 2 * SHM_V + 2 * SHM_K + NW * 64 * 4;
using bf16x8 = __attribute__((ext_vector_type(8))) short;
using s16x4  = __attribute__((ext_vector_type(4))) short;
using f32x16 = __attribute__((ext_vector_type(16))) float;
using f32x8  = __attribute__((ext_vector_type(8))) float;
using u32x4  = __attribute__((ext_vector_type(4))) unsigned;
#define KSWZ(row, colB) ((row) * 256 + ((colB) ^ (((row) & 7) << 4)))
#define SBAR() __builtin_amdgcn_sched_barrier(0)
__device__ __forceinline__ int crow(int r, int hi) { return (r & 3) + 8 * (r >> 2) + 4 * hi; }
__device__ __forceinline__ unsigned cvtpk(float lo, float hi) {
  unsigned r; asm volatile("v_cvt_pk_bf16_f32 %0, %1, %2" : "=v"(r) : "v"(lo), "v"(hi)); return r;
}
template <typename TIn> struct Stage;
template <> struct Stage<bf16>  { using T = bf16x8;
  __device__ static __forceinline__ T ld8(const bf16* p) { return *reinterpret_cast<const bf16x8*>(p); }
  __device__ static __forceinline__ bf16x8 tobf(T x) { return x; } };
template <> struct Stage<float> { using T = f32x8;
  __device__ static __forceinline__ T ld8(const float* p) { return *reinterpret_cast<const f32x8*>(p); }
  __device__ static __forceinline__ bf16x8 tobf(T x) {
    u32x4 w = {cvtpk(x[0], x[1]), cvtpk(x[2], x[3]), cvtpk(x[4], x[5]), cvtpk(x[6], x[7])}; return *reinterpret_cast<bf16x8*>(&w); } };

__device__ __forceinline__ void partialSM(f32x16& p0, f32x16& p1, float& m_reg, float& mn, float& alpha) {
  constexpr float C = SCALE * 1.4426950408889634f;
  float pmax = p0[0]; for (int r = 1; r < 16; ++r) pmax = fmaxf(pmax, p0[r]); for (int r = 0; r < 16; ++r) pmax = fmaxf(pmax, p1[r]);
  { auto rr = __builtin_amdgcn_permlane32_swap(__float_as_uint(pmax), __float_as_uint(pmax), false, false);
    pmax = fmaxf(__uint_as_float(rr[0]), __uint_as_float(rr[1])); }
  if (__builtin_expect(__all(pmax - m_reg <= THR / SCALE), 1)) { mn = m_reg; alpha = 1.f; }
  else { mn = fmaxf(m_reg, pmax); alpha = __builtin_amdgcn_exp2f((m_reg - mn) * C); m_reg = mn; }
  float mnC = -mn * C;
  for (int r = 0; r < 16; ++r) p0[r] = fmaf(p0[r], C, mnC); for (int r = 0; r < 16; ++r) p1[r] = fmaf(p1[r], C, mnC);
  for (int r = 0; r < 16; ++r) p0[r] = __builtin_amdgcn_exp2f(p0[r]);
}
__device__ __forceinline__ void finishSM(f32x16& p0, f32x16& p1, float alpha, float& l_reg, bf16x8& pa0, bf16x8& pa1, bf16x8& pa2, bf16x8& pa3) {
  for (int r = 0; r < 16; ++r) p1[r] = __builtin_amdgcn_exp2f(p1[r]);
  float ps = 0; for (int r = 0; r < 16; ++r) ps += p0[r]; for (int r = 0; r < 16; ++r) ps += p1[r];
  { auto rr = __builtin_amdgcn_permlane32_swap(__float_as_uint(ps), __float_as_uint(ps), false, false);
    ps = __uint_as_float(rr[0]) + __uint_as_float(rr[1]); }
  l_reg = l_reg * alpha + ps;
#define PK4(P, BASE, OUT) do { unsigned a0 = cvtpk(P[BASE + 0], P[BASE + 1]), a1 = cvtpk(P[BASE + 2], P[BASE + 3]);   \
    unsigned b0 = cvtpk(P[BASE + 4], P[BASE + 5]), b1 = cvtpk(P[BASE + 6], P[BASE + 7]);                              \
    auto r0 = __builtin_amdgcn_permlane32_swap(a0, b0, false, false); auto r1 = __builtin_amdgcn_permlane32_swap(a1, b1, false, false); \
    u32x4 w = {r0[0], r1[0], r0[1], r1[1]}; OUT = *reinterpret_cast<bf16x8*>(&w); } while (0)
  PK4(p0, 0, pa0); PK4(p0, 8, pa1); PK4(p1, 0, pa2); PK4(p1, 8, pa3);
#undef PK4
}
__device__ __forceinline__ void qkt(f32x16& p0, f32x16& p1, const bf16* Ks, const bf16x8* qr, int r32, int hi) {
  p0 = f32x16{}; p1 = f32x16{};
  for (int d0 = 0; d0 < 8; ++d0) { int cb = (d0 * 16 + hi * 8) * 2;
    bf16x8 b0 = *reinterpret_cast<const bf16x8*>((const char*)Ks + KSWZ(r32, cb));
    bf16x8 b1 = *reinterpret_cast<const bf16x8*>((const char*)Ks + KSWZ(32 + r32, cb));
    p0 = __builtin_amdgcn_mfma_f32_32x32x16_bf16(b0, qr[d0], p0, 0, 0, 0);
    p1 = __builtin_amdgcn_mfma_f32_32x32x16_bf16(b1, qr[d0], p1, 0, 0, 0); }
}
__device__ __forceinline__ int v_st(int k, int c) { const int kk = (k & ~0xC) | ((k & 4) << 1) | ((k & 8) >> 1); return ((kk >> 3) * 4 + (c >> 5)) * 512 + ((kk & 7) * 32 + (c & 31)) * 2; }
__device__ __forceinline__ int v_rd_base(int lane) { return ((lane & 3) << 3) | (((lane >> 2) & 3) << 6) | (((lane >> 4) & 1) << 5) | (((lane >> 5) & 1) << 8); }
constexpr int v_rd_off(int d0, int ks, int half) { return d0 * 512 + ks * 4096 + half * 2048; }
template <int OFF> __device__ __forceinline__ s16x4 tr_read(int vb) {
  s16x4 r; asm volatile("ds_read_b64_tr_b16 %0, %1 offset:%2" : "=&v"(r) : "v"(vb), "i"(OFF) : "memory"); return r;
}
template <int D0> __device__ __forceinline__ void pv_one(f32x16& od, int vb, bf16x8 pa0, bf16x8 pa1, bf16x8 pa2, bf16x8 pa3) {
  const s16x4 l0 = tr_read<v_rd_off(D0, 0, 0)>(vb), h0 = tr_read<v_rd_off(D0, 0, 1)>(vb), l1 = tr_read<v_rd_off(D0, 1, 0)>(vb), h1 = tr_read<v_rd_off(D0, 1, 1)>(vb);
  const s16x4 l2 = tr_read<v_rd_off(D0, 2, 0)>(vb), h2 = tr_read<v_rd_off(D0, 2, 1)>(vb), l3 = tr_read<v_rd_off(D0, 3, 0)>(vb), h3 = tr_read<v_rd_off(D0, 3, 1)>(vb);
  asm volatile("s_waitcnt lgkmcnt(0)" ::: "memory"); SBAR();
#define PK(L, H) (bf16x8){L[0], L[1], L[2], L[3], H[0], H[1], H[2], H[3]}
  od = __builtin_amdgcn_mfma_f32_32x32x16_bf16(pa0, PK(l0, h0), od, 0, 0, 0);
  od = __builtin_amdgcn_mfma_f32_32x32x16_bf16(pa1, PK(l1, h1), od, 0, 0, 0);
  od = __builtin_amdgcn_mfma_f32_32x32x16_bf16(pa2, PK(l2, h2), od, 0, 0, 0);
  od = __builtin_amdgcn_mfma_f32_32x32x16_bf16(pa3, PK(l3, h3), od, 0, 0, 0);
#undef PK
}
__device__ __forceinline__ void pv_d0(f32x16* o, int vb, bf16x8 pa0, bf16x8 pa1, bf16x8 pa2, bf16x8 pa3) {
  pv_one<0>(o[0], vb, pa0, pa1, pa2, pa3); pv_one<1>(o[1], vb, pa0, pa1, pa2, pa3); pv_one<2>(o[2], vb, pa0, pa1, pa2, pa3); pv_one<3>(o[3], vb, pa0, pa1, pa2, pa3);
}
__device__ __forceinline__ void pv_one_f16(f32x16& od, int vb, bf16x8 pa0, bf16x8 pa1, bf16x8 pa2, bf16x8 pa3) {
  typedef _Float16 h8 __attribute__((ext_vector_type(8)));
  const s16x4 l0 = tr_read<v_rd_off(0, 0, 0)>(vb), h0 = tr_read<v_rd_off(0, 0, 1)>(vb), l1 = tr_read<v_rd_off(0, 1, 0)>(vb), h1 = tr_read<v_rd_off(0, 1, 1)>(vb);
  const s16x4 l2 = tr_read<v_rd_off(0, 2, 0)>(vb), h2 = tr_read<v_rd_off(0, 2, 1)>(vb), l3 = tr_read<v_rd_off(0, 3, 0)>(vb), h3 = tr_read<v_rd_off(0, 3, 1)>(vb);
  asm volatile("s_waitcnt lgkmcnt(0)" ::: "memory"); SBAR();
#define PKH(L, H) __builtin_bit_cast(h8, (bf16x8){L[0], L[1], L[2], L[3], H[0], H[1], H[2], H[3]})
  od = __builtin_amdgcn_mfma_f32_32x32x16_f16(__builtin_bit_cast(h8, pa0), PKH(l0, h0), od, 0, 0, 0);
  od = __builtin_amdgcn_mfma_f32_32x32x16_f16(__builtin_bit_cast(h8, pa1), PKH(l1, h1), od, 0, 0, 0);
  od = __builtin_amdgcn_mfma_f32_32x32x16_f16(__builtin_bit_cast(h8, pa2), PKH(l2, h2), od, 0, 0, 0);
  od = __builtin_amdgcn_mfma_f32_32x32x16_f16(__builtin_bit_cast(h8, pa3), PKH(l3, h3), od, 0, 0, 0);
#undef PKH
}
template <typename TQ_unused = void>
__device__ __forceinline__ void attn_dense_body(const bf16* __restrict__ Qb, const bf16* __restrict__ Kh, const bf16* __restrict__ Vh,
                                                const bf16* __restrict__ Zb, bf16* __restrict__ Ob, int seq, char* lds) {
  using TQ = bf16;
  using St = Stage<bf16>; using SQ = Stage<TQ>;
  int tid_ = threadIdx.x; asm volatile("" : "+v"(tid_));
  const int tid = tid_, wid = tid >> 6, lane = tid & 63, r32 = lane & 31, hi = lane >> 5;
  bf16* V_lds = (bf16*)lds; bf16* K_lds = (bf16*)(lds + 2 * SHM_V);
  float* ws = (float*)(lds + 2 * SHM_V + 2 * SHM_K) + wid * 64; float* li_l = ws; float* al_l = ws + 32;
  float m_reg = -1e30f, l_reg = 0; f32x16 o[4] = {}; bf16x8 qr[8];
  const TQ* Qw = Qb + (long)(wid * QBLK + r32) * LDQ + hi * 8;
#pragma unroll
  for (int d0 = 0; d0 < 8; ++d0) qr[d0] = SQ::tobf(SQ::ld8(Qw + d0 * 16));
  const int sr = tid >> 4, sc = (tid & 15) * 8, vst0 = v_st(sr, sc), vst1 = v_st(32 + sr, sc);
  const int vb0 = (int)(uintptr_t)V_lds + v_rd_base(lane);
  struct { typename St::T vs0, vs1, ks0, ks1; } sr_[SDEPTH];
#define SLOAD(i, k0) do { sr_[i].vs0 = St::ld8(&Vh[(long)((k0) + sr) * LDK + sc]); sr_[i].vs1 = St::ld8(&Vh[(long)((k0) + 32 + sr) * LDK + sc]); \
    sr_[i].ks0 = St::ld8(&Kh[(long)((k0) + sr) * LDK + sc]); sr_[i].ks1 = St::ld8(&Kh[(long)((k0) + 32 + sr) * LDK + sc]); } while (0)
#define SWRITE(b, i) do { *(bf16x8*)((char*)V_lds + (b) * SHM_V + vst0) = St::tobf(sr_[i].vs0);          \
    *(bf16x8*)((char*)V_lds + (b) * SHM_V + vst1) = St::tobf(sr_[i].vs1); int kc = sc * 2;               \
    *(bf16x8*)((char*)K_lds + (b) * SHM_K + KSWZ(sr, kc)) = St::tobf(sr_[i].ks0);                       \
    *(bf16x8*)((char*)K_lds + (b) * SHM_K + KSWZ(32 + sr, kc)) = St::tobf(sr_[i].ks1); } while (0)
#define SWAIT() do { if constexpr (SDEPTH == 2) asm volatile("s_waitcnt vmcnt(4)" ::: "memory"); else asm volatile("s_waitcnt vmcnt(0)" ::: "memory"); } while (0)
#define RESC(a) do { if (__any((a) < 1.f)) { if (hi == 0) al_l[r32] = (a); asm volatile("s_waitcnt lgkmcnt(0)" ::: "memory"); \
    for (int d = 0; d < 4; ++d) for (int r = 0; r < 16; ++r) o[d][r] *= al_l[crow(r, hi)]; } } while (0)
  f32x16 pA0, pA1, pB0, pB1; float mnA, mnB, alA, alB; bf16x8 pa0, pa1, pa2, pa3; const int NT = seq / KVBLK;
  constexpr int SE = 0, SO = SDEPTH - 1;
  SLOAD(SE, 0); asm volatile("s_waitcnt vmcnt(0)" ::: "memory"); SWRITE(0, SE); __syncthreads();
  qkt(pA0, pA1, K_lds, qr, r32, hi); partialSM(pA0, pA1, m_reg, mnA, alA);
  SLOAD(SO, KVBLK); if constexpr (SDEPTH == 2) { if (2 < NT) SLOAD(SE, 2 * KVBLK); }
  SWAIT(); SWRITE(1, SO); __syncthreads();
  for (int j = 1; j + 1 < NT; j += 2) {
    SBAR(); qkt(pB0, pB1, (bf16*)((char*)K_lds + SHM_K), qr, r32, hi);
    finishSM(pA0, pA1, alA, l_reg, pa0, pa1, pa2, pa3); SBAR();
    SLOAD(SO, (j + SDEPTH) * KVBLK); SBAR();
    pv_d0(o, vb0, pa0, pa1, pa2, pa3); partialSM(pB0, pB1, m_reg, mnB, alB);
    __syncthreads(); SWAIT(); SWRITE(0, SE);
    RESC(alB); __syncthreads();
    SBAR(); qkt(pA0, pA1, K_lds, qr, r32, hi);
    finishSM(pB0, pB1, alB, l_reg, pa0, pa1, pa2, pa3); SBAR();
    if (SDEPTH == 1 || j + 3 < NT) SLOAD(SE, (j + 1 + SDEPTH) * KVBLK); SBAR();
    pv_d0(o, vb0 + (int)SHM_V, pa0, pa1, pa2, pa3); partialSM(pA0, pA1, m_reg, mnA, alA);
    __syncthreads(); SWAIT(); SWRITE(1, SO);
    RESC(alA); __syncthreads();
  }
  SBAR(); qkt(pB0, pB1, (bf16*)((char*)K_lds + SHM_K), qr, r32, hi);
  finishSM(pA0, pA1, alA, l_reg, pa0, pa1, pa2, pa3); SBAR();
  pv_d0(o, vb0, pa0, pa1, pa2, pa3); partialSM(pB0, pB1, m_reg, mnB, alB);
  __syncthreads(); RESC(alB);
  finishSM(pB0, pB1, alB, l_reg, pa0, pa1, pa2, pa3); SBAR();
  pv_d0(o, vb0 + (int)SHM_V, pa0, pa1, pa2, pa3);
  if (hi == 0) li_l[r32] = l_reg; asm volatile("s_waitcnt lgkmcnt(0)" ::: "memory");
  float rli[16];
#pragma unroll
  for (int r = 0; r < 16; ++r) rli[r] = __builtin_amdgcn_rcpf(li_l[crow(r, hi)]);
  bf16* Ow = Ob + (long)(wid * QBLK) * LDO; const bf16* Zw = Zb + (long)(wid * QBLK) * LDZ;
#pragma unroll
  for (int rg = 0; rg < 4; ++rg) {
    float zv[4][4];
#pragma unroll
    for (int rr = 0; rr < 4; ++rr)
#pragma unroll
      for (int d0 = 0; d0 < 4; ++d0) zv[rr][d0] = __bfloat162float(Zw[(long)crow(4 * rg + rr, hi) * LDZ + d0 * 32 + r32]);
#pragma unroll
    for (int rr = 0; rr < 4; ++rr) { const int r = 4 * rg + rr, orow = crow(r, hi);
#pragma unroll
      for (int d0 = 0; d0 < 4; ++d0) { const float z = zv[rr][d0]; const float gte = z * __builtin_amdgcn_rcpf(1.f + __expf(-z));
        Ow[(long)orow * LDO + d0 * 32 + r32] = __float2bfloat16(o[d0][r] * rli[r] * gte); } }
    asm volatile("" ::: "memory");
  }
#undef SLOAD
#undef SWRITE
#undef SWAIT
#undef RESC
}
}

#define GAS __attribute__((address_space(1)))
#define LAS __attribute__((address_space(3)))
namespace cg = cooperative_groups;
typedef unsigned short u16;
typedef unsigned v4u __attribute__((ext_vector_type(4)));
typedef unsigned v2u __attribute__((ext_vector_type(2)));
typedef float f32x4 __attribute__((ext_vector_type(4)));
typedef float f32x2 __attribute__((ext_vector_type(2)));
typedef float f32x16 __attribute__((ext_vector_type(16)));
typedef short s16x8 __attribute__((ext_vector_type(8)));
typedef short s16x4 __attribute__((ext_vector_type(4)));
typedef _Float16 f16x8 __attribute__((ext_vector_type(8)));
#define LDS_WAIT() asm volatile("s_waitcnt lgkmcnt(0)" ::: "memory")

constexpr int NWAVES = 8, NTHR = 512;
constexpr int BATCH = 2, SEQ = 8192, DM = 1024, M = BATCH * SEQ, N0 = 3072, N1 = 2560;
constexpr float EPS = 1e-6f;
constexpr size_t MiB = 1u << 20, KiB = 1024;
constexpr size_t WS_CTL = 0, CTL_ZERO_BYTES = 64 * KiB;
constexpr int CW_BAR = 1024;
constexpr size_t WS_TFC = 1 * MiB, WS_T128 = WS_TFC + 64 * KiB, WS_TTW = WS_T128 + 64 * KiB, WS_T64 = WS_TTW + 64 * KiB, WS_TROPE = WS_T64 + 32 * KiB;
constexpr size_t WS_SSP = 2 * MiB;
constexpr size_t WS_W0IN = 3 * MiB, WS_W0OUT = 9 * MiB, WS_W1IN = 11 * MiB, WS_W1OUT = 16 * MiB;
constexpr size_t WS_XN = 18 * MiB;
constexpr size_t WS_PROJ = 50 * MiB;
constexpr size_t WS_ABUF = 146 * MiB;
constexpr size_t WS_YCAT = 178 * MiB;
constexpr size_t WS_END = 210 * MiB;
constexpr int RING_BYTES = 131072, MISC_OFF = RING_BYTES + 320, LDS_BYTES = 147456;

__device__ __forceinline__ unsigned f2bf(float f) { unsigned u = __builtin_bit_cast(unsigned, f); return (u + 0x7fffu + ((u >> 16) & 1u)) >> 16; }
__device__ __forceinline__ unsigned pk2(float lo, float hi) { return f2bf(lo) | (f2bf(hi) << 16); }
__device__ __forceinline__ float bflo(unsigned w) { return __builtin_bit_cast(float, w << 16); }
__device__ __forceinline__ float bfhi(unsigned w) { return __builtin_bit_cast(float, w & 0xffff0000u); }
__device__ __forceinline__ u16 f2h(float f) { const _Float16 h = (_Float16)f; return __builtin_bit_cast(u16, h); }
__device__ __forceinline__ float silu(float z) { return z / (1.f + __expf(-z)); }
__device__ __forceinline__ int crow(int r, int hi) { return (r & 3) + 8 * (r >> 2) + 4 * hi; }


#define XB_TMO      128
#define XB_XCNT(j)  (256  + 64 * (j))
#define XB_XSUB(j)  (1280 + 64 * (j))
#define XB_XGEN(j)  (2304 + 64 * (j))
#define XB_TOP      3328
#define XB_TOPGEN   3392
#define XCD_BAR_WORDS 3456
#define XB_SPIN_CAP (1u << 18)

__device__ __forceinline__ unsigned xb_ld(unsigned* p)              { return __hip_atomic_load(p, __ATOMIC_RELAXED, __HIP_MEMORY_SCOPE_AGENT); }
__device__ __forceinline__ unsigned xb_add(unsigned* p, unsigned v) { return __hip_atomic_fetch_add(p, v, __ATOMIC_RELAXED, __HIP_MEMORY_SCOPE_AGENT); }
__device__ __forceinline__ unsigned xb_xcc_id() { return (unsigned)__builtin_amdgcn_s_getreg((3 << 11) | 20) & 0xFu; }
#define XB_SPIN(cond, bar) do { unsigned _sp = 0; while (cond) { __builtin_amdgcn_s_sleep(1); \
    if ((++_sp & 255u) == 0u) { if (xb_ld(&(bar)[XB_TMO])) break; if (_sp > XB_SPIN_CAP) { atomicAdd(&(bar)[XB_TMO], 1u); break; } } } } while (0)

struct XcdBarrier {
    unsigned* bar; unsigned x;
    volatile LAS unsigned* st;
};

__device__ __forceinline__ XcdBarrier xcd_barrier_post(unsigned* bar, volatile LAS unsigned* st) {
    XcdBarrier b; b.bar = bar; b.x = xb_xcc_id(); b.st = st;
    if (threadIdx.x == 0) (void)xb_add(&bar[XB_XCNT(b.x)], 1u);
    return b;
}
__device__ __forceinline__ void xcd_barrier_complete(unsigned* bar, unsigned x, unsigned& nloc, unsigned& nx) {
    const unsigned G = gridDim.x * gridDim.y * gridDim.z;
    unsigned sum, cnt, mine, sp = 0u;
    for (;;) {
        sum = 0u; cnt = 0u; mine = 0u;
#pragma unroll
        for (unsigned j = 0; j < 16; ++j) { const unsigned c = xb_ld(&bar[XB_XCNT(j)]); sum += c; cnt += (c > 0u) ? 1u : 0u; mine = (j == x) ? c : mine; }
        if (sum == G) break;
        __builtin_amdgcn_s_sleep(1);
        if ((++sp & 255u) == 0u) { if (xb_ld(&bar[XB_TMO])) break; if (sp > XB_SPIN_CAP) { atomicAdd(&bar[XB_TMO], 1u); break; } }
    }
    nloc = mine > 0u ? mine : 1u; nx = cnt > 0u ? cnt : 1u;
}

__device__ __forceinline__ void xcd_barrier(const XcdBarrier& b) {
    asm volatile("s_waitcnt vmcnt(0)" ::: "memory");
    __syncthreads();
    if (threadIdx.x == 0) {
        unsigned* bar = b.bar;
        __builtin_amdgcn_s_waitcnt(0);
        unsigned nloc = b.st[0], nx = b.st[1];
        if (nloc == 0u) { xcd_barrier_complete(bar, b.x, nloc, nx); b.st[0] = nloc; b.st[1] = nx; }
        const unsigned old = xb_add(&bar[XB_XSUB(b.x)], 1u);
        const unsigned gen = old / nloc;
        if (old + 1u == (gen + 1u) * nloc) {
            __builtin_amdgcn_fence(__ATOMIC_RELEASE, "agent");
            asm volatile("s_waitcnt vmcnt(0)" ::: "memory");
            const unsigned og = xb_add(&bar[XB_TOP], 1u);
            const unsigned tg = og / nx;
            if (og + 1u == (tg + 1u) * nx) xb_add(&bar[XB_TOPGEN], 1u);
            else XB_SPIN(xb_ld(&bar[XB_TOPGEN]) == tg, bar);
            __builtin_amdgcn_fence(__ATOMIC_ACQUIRE, "agent");
            xb_add(&bar[XB_XGEN(b.x)], 1u);
            asm volatile("s_waitcnt vmcnt(0)" ::: "memory");
        } else {
            XB_SPIN(xb_ld(&bar[XB_XGEN(b.x)]) == gen, bar);
            __builtin_amdgcn_fence(__ATOMIC_ACQUIRE, "agent");
            asm volatile("s_waitcnt vmcnt(0)" ::: "memory");
        }
    }
    __syncthreads();
}


struct Args { const float* in[11]; float* out; unsigned char* ws; int ph_lo, ph_hi, coop, pad; };

__device__ __forceinline__ float wave_sum(float v) {
#pragma unroll
    for (int o = 1; o < 64; o <<= 1) v += __shfl_xor(v, o);
    return v;
}
__device__ __forceinline__ void p0_transpose_item(const float* W, int K, int N, u16* WT, LAS float* scr, int item, int lane) {
    const int nblk = N / 32, kb = item / nblk, nb = item % nblk, k0 = 64 * kb, n0 = 32 * nb;
#pragma unroll 8
    for (int i = 0; i < 32; ++i) { const int kk = 2 * i + (lane >> 5); scr[kk * 33 + (lane & 31)] = W[(size_t)(k0 + kk) * N + n0 + (lane & 31)]; }
    LDS_WAIT(); asm volatile("" ::: "memory");
    const int c = lane & 7;
#pragma unroll
    for (int j = 0; j < 4; ++j) { const int n = (lane >> 3) + 8 * j; const LAS float* s = scr + (8 * c) * 33 + n;
        v4u o; o.x = pk2(s[0 * 33], s[1 * 33]); o.y = pk2(s[2 * 33], s[3 * 33]); o.z = pk2(s[4 * 33], s[5 * 33]); o.w = pk2(s[6 * 33], s[7 * 33]);
        *(v4u*)(WT + (size_t)(n0 + n) * K + k0 + 8 * c) = o; }
    LDS_WAIT(); asm volatile("" ::: "memory");
}
__device__ __forceinline__ void p0_prologue(const Args& a, LAS unsigned char* lds, int gw, int NGW, int wave, int lane) {
    unsigned char* ws = a.ws;
    LAS float* scr = (LAS float*)(lds + wave * 16384);
    constexpr int I0 = (DM / 64) * (N0 / 32), I1 = (DM / 64) * (DM / 32), I2 = (DM / 64) * (N1 / 32), I3 = I1, NITEMS = I0 + I1 + I2 + I3;
    for (int it = gw; it < NITEMS; it += NGW) {
        int r = it;
        if (r < I0) { p0_transpose_item(a.in[2], DM, N0, (u16*)(ws + WS_W0IN), scr, r, lane); continue; } r -= I0;
        if (r < I1) { p0_transpose_item(a.in[4], DM, DM, (u16*)(ws + WS_W0OUT), scr, r, lane); continue; } r -= I1;
        if (r < I2) { p0_transpose_item(a.in[6], DM, N1, (u16*)(ws + WS_W1IN), scr, r, lane); continue; } r -= I2;
        p0_transpose_item(a.in[9], DM, DM, (u16*)(ws + WS_W1OUT), scr, r, lane);
    }
    const float* x = a.in[0]; const float* g0 = a.in[1]; u16* XN = (u16*)(ws + WS_XN);
    f32x4 gv[4];
#pragma unroll
    for (int j = 0; j < 4; ++j) gv[j] = ((const f32x4*)g0)[lane + 64 * j];
    for (int m = gw; m < M; m += NGW) {
        const f32x4* xr = (const f32x4*)(x + (size_t)m * DM) + lane; f32x4 v[4]; float s = 0.f;
#pragma unroll
        for (int j = 0; j < 4; ++j) { v[j] = xr[64 * j]; s += (v[j][0] * v[j][0] + v[j][1] * v[j][1]) + (v[j][2] * v[j][2] + v[j][3] * v[j][3]); }
        const float r = 1.0f / sqrtf(wave_sum(s) * (1.0f / DM) + EPS);
        unsigned long long* o8 = (unsigned long long*)(XN + (size_t)m * DM) + lane;
#pragma unroll
        for (int j = 0; j < 4; ++j) { const f32x4 y = v[j] * r * gv[j]; o8[64 * j] = (unsigned long long)pk2(y[0], y[1]) | ((unsigned long long)pk2(y[2], y[3]) << 32); }
    }
    const int gt = gw * 64 + lane, NGT = NGW * 64;
    u16* TFC = (u16*)(ws + WS_TFC); u16* T128 = (u16*)(ws + WS_T128); u16* T64 = (u16*)(ws + WS_T64); f32x2* TTW = (f32x2*)(ws + WS_TTW); f32x2* TROPE = (f32x2*)(ws + WS_TROPE);
    for (int i = gt; i < 32768; i += NGT) {
        const int e = i & 7, ln = (i >> 3) & 63, j = (i >> 9) & 7, cb = i >> 12, lp = 32 * cb + (ln & 31), c = 16 * j + 8 * (ln >> 5) + e;
        const int l = lp & 127, ph = (l * c) & 127; const float xx = (float)ph * (1.0f / 64.0f);
        TFC[i] = f2h(lp < 128 ? cospif(xx) : -sinpif(xx));
    }
    for (int i = gt; i < 32768; i += NGT) {
        const int e = i & 7, ln = (i >> 3) & 63, j = (i >> 9) & 3, vt = (i >> 11) & 3, rt = i >> 13, k2 = 32 * rt + (ln & 31), s2 = 64 * (vt & 1) + 16 * j + 8 * (ln >> 5) + e;
        const int ph = (k2 * s2) & 127; const float xx = (float)ph * (1.0f / 64.0f);
        T128[i] = f2h((vt >> 1) ? sinpif(xx) : cospif(xx));
    }
    for (int i = gt; i < 12288; i += NGT) {
        const int e = i & 7, ln = (i >> 3) & 63, ch = (i >> 9) & 3, mt = (i >> 11) & 1, ty = i >> 12, k1 = 32 * mt + (ln & 31), s1 = 16 * ch + (e & 3) + 8 * (e >> 2) + 4 * (ln >> 5);
        const int ph = (k1 * s1) & 63; const float xx = (float)ph * (1.0f / 32.0f);
        T64[i] = f2h(ty == 0 ? cospif(xx) : (ty == 1 ? sinpif(xx) : -sinpif(xx)));
    }
    for (int i = gt; i < 8192; i += NGT) {
        const int k1 = i & 63, s2 = i >> 6; const float xx = (float)(k1 * s2) * (1.0f / 4096.0f);
        TTW[i] = (f32x2){cospif(xx), sinpif(xx)};
    }
    for (int i = gt; i < 4096; i += NGT) {
        const int j = i & 31, pos = i >> 5; const float inv = powf(10000.0f, -(float)j / 32.0f); const float ang = (float)pos * inv;
        TROPE[i] = (f32x2){cosf(ang), sinf(ang)};
    }
}

__device__ __forceinline__ void unpack8(const v4u w, float (&f)[8]) { f[0] = bflo(w.x); f[1] = bfhi(w.x); f[2] = bflo(w.y); f[3] = bfhi(w.y); f[4] = bflo(w.z); f[5] = bfhi(w.z); f[6] = bflo(w.w); f[7] = bfhi(w.w); }
__device__ __forceinline__ void p2_conv(const Args& a, int gtid, int ngt) {
    const u16* P = (const u16*)(a.ws + WS_PROJ); u16* Y = (u16*)(a.ws + WS_YCAT); const float* cw = a.in[3];
    for (int idx = gtid; idx < M * 64; idx += ngt) {
        const int t = idx >> 6, c8 = (idx & 63) * 8, s = t & (SEQ - 1);
        const u16* row = P + (size_t)t * N0 + c8;
        const v4u z4 = {0u, 0u, 0u, 0u};
        const v4u ax1 = *(const v4u*)(row), ab1 = *(const v4u*)(row + 512), ac1 = *(const v4u*)(row + 1024), az1 = *(const v4u*)(row + 1536);
        const v4u ax0 = s > 0 ? *(const v4u*)(row - N0) : z4, ac0 = s > 0 ? *(const v4u*)(row - N0 + 1024) : z4;
        const v4u ax2 = s < SEQ - 1 ? *(const v4u*)(row + N0) : z4, ac2 = s < SEQ - 1 ? *(const v4u*)(row + N0 + 1024) : z4;
        float w0[8], w1[8], w2[8];
        { const f32x4 q0 = *(const f32x4*)(cw + c8), q1 = *(const f32x4*)(cw + c8 + 4); for (int i = 0; i < 4; ++i) { w0[i] = q0[i]; w0[4 + i] = q1[i]; } }
        { const f32x4 q0 = *(const f32x4*)(cw + 512 + c8), q1 = *(const f32x4*)(cw + 512 + c8 + 4); for (int i = 0; i < 4; ++i) { w1[i] = q0[i]; w1[4 + i] = q1[i]; } }
        { const f32x4 q0 = *(const f32x4*)(cw + 1024 + c8), q1 = *(const f32x4*)(cw + 1024 + c8 + 4); for (int i = 0; i < 4; ++i) { w2[i] = q0[i]; w2[4 + i] = q1[i]; } }
        float x0[8], x1[8], x2[8], c0[8], c1[8], c2[8], bb[8], zz[8], y[8];
        unpack8(ax0, x0); unpack8(ax1, x1); unpack8(ax2, x2); unpack8(ac0, c0); unpack8(ac1, c1); unpack8(ac2, c2); unpack8(ab1, bb); unpack8(az1, zz);
#pragma unroll
        for (int i = 0; i < 8; ++i) { const float cv = (c0[i] * x0[i]) * w0[i] + (c1[i] * x1[i]) * w1[i] + (c2[i] * x2[i]) * w2[i]; y[i] = bb[i] * cv * silu(zz[i]); }
        v4u o; o.x = pk2(y[0], y[1]); o.y = pk2(y[2], y[3]); o.z = pk2(y[4], y[5]); o.w = pk2(y[6], y[7]);
        *(v4u*)(Y + (size_t)t * DM + c8) = o;
    }
}

#define MFMA16(a, b, c) __builtin_amdgcn_mfma_f32_32x32x16_f16(__builtin_bit_cast(f16x8, a), __builtin_bit_cast(f16x8, b), (c), 0, 0, 0)
__device__ __forceinline__ s16x8 pack8h(const f32x16& x, int s) {
    v4u p;
    p.x = (unsigned)f2h(x[8 * s + 0]) | ((unsigned)f2h(x[8 * s + 1]) << 16); p.y = (unsigned)f2h(x[8 * s + 2]) | ((unsigned)f2h(x[8 * s + 3]) << 16);
    p.z = (unsigned)f2h(x[8 * s + 4]) | ((unsigned)f2h(x[8 * s + 5]) << 16); p.w = (unsigned)f2h(x[8 * s + 6]) | ((unsigned)f2h(x[8 * s + 7]) << 16);
    return __builtin_bit_cast(s16x8, p);
}
__device__ __forceinline__ void p2_fft1(const Args& a, int G, int wave, int lane) {
    const u16* P = (const u16*)(a.ws + WS_PROJ); u16* AB = (u16*)(a.ws + WS_ABUF);
    const s16x8* TFC = (const s16x8*)(a.ws + WS_TFC); const s16x8* T64 = (const s16x8*)(a.ws + WS_T64); const f32x2* TTW = (const f32x2*)(a.ws + WS_TTW);
    const int q = wave & 3, m = lane & 31, h = lane >> 5;
    for (int it = (int)blockIdx.x * 2 + (wave >> 2); it < 1024; it += 2 * G) {
        const int b = it >> 9, s2 = (it >> 2) & 127, g = it & 3;
        const u16* ub = P + ((size_t)(b * SEQ + s2 + 128 * m)) * N0 + 2048 + g * 128 + 8 * h;
        f32x16 Tr0 = {}, Tr1 = {}, Ti0 = {}, Ti1 = {};
#pragma unroll
        for (int j = 0; j < 8; ++j) {
            const s16x8 a0 = *(const s16x8*)(ub + 16 * j), a1 = *(const s16x8*)(ub + (size_t)32 * 128 * N0 + 16 * j);
            const s16x8 br = TFC[(q * 8 + j) * 64 + lane], bi = TFC[((4 + q) * 8 + j) * 64 + lane];
            Tr0 = MFMA16(a0, br, Tr0); Tr1 = MFMA16(a1, br, Tr1); Ti0 = MFMA16(a0, bi, Ti0); Ti1 = MFMA16(a1, bi, Ti1);
        }
        s16x8 Btr[4], Bti[4];
        Btr[0] = pack8h(Tr0, 0); Btr[1] = pack8h(Tr0, 1); Btr[2] = pack8h(Tr1, 0); Btr[3] = pack8h(Tr1, 1);
        Bti[0] = pack8h(Ti0, 0); Bti[1] = pack8h(Ti0, 1); Bti[2] = pack8h(Ti1, 0); Bti[3] = pack8h(Ti1, 1);
#pragma unroll
        for (int mt = 0; mt < 2; ++mt) {
            f32x16 Dr = {}, Di = {};
#pragma unroll
            for (int ch = 0; ch < 4; ++ch) {
                const s16x8 C = T64[((0 * 2 + mt) * 4 + ch) * 64 + lane], S = T64[((1 * 2 + mt) * 4 + ch) * 64 + lane], nS = T64[((2 * 2 + mt) * 4 + ch) * 64 + lane];
                Dr = MFMA16(C, Btr[ch], Dr); Dr = MFMA16(S, Bti[ch], Dr); Di = MFMA16(C, Bti[ch], Di); Di = MFMA16(nS, Btr[ch], Di);
            }
#pragma unroll
            for (int r = 0; r < 16; ++r) {
                const int k1 = 32 * mt + crow(r, h); const f32x2 tw = TTW[s2 * 64 + k1];
                const float ar = Dr[r] * tw[0] + Di[r] * tw[1], ai = Di[r] * tw[0] - Dr[r] * tw[1];
                u16* dst = AB + ((((size_t)(b * 64 + k1) * 4 + g) * 2) * 128 + s2) * 128 + 32 * q + m;
                dst[0] = f2h(ar); dst[128 * 128] = f2h(ai);
            }
        }
    }
}

__device__ __forceinline__ void p3_fft2(const Args& a, unsigned char* lds, int G, int tid, int wave, int lane) {
    const u16* AB = (const u16*)(a.ws + WS_ABUF); const u16* P = (const u16*)(a.ws + WS_PROJ); u16* Y = (u16*)(a.ws + WS_YCAT);
    const s16x8* T128 = (const s16x8*)(a.ws + WS_T128);
    const int sr = tid >> 4, sc = (tid & 15) * 8, vst0 = att::v_st(sr, sc), vst1 = att::v_st(32 + sr, sc);
    const int rt = wave & 3, cbp = wave >> 2, r32 = lane & 31, hi = lane >> 5;
    const int vb = (int)(uintptr_t)lds + att::v_rd_base(lane) + (2 * cbp) * 512;
    for (int it = (int)blockIdx.x; it < 512; it += G) {
        const int b = it >> 8, k1 = (it >> 2) & 63, g = it & 3;
        const u16* src = AB + (size_t)it * 32768;
        s16x8 st[8];
#pragma unroll
        for (int vt = 0; vt < 4; ++vt) { st[2 * vt] = *(const s16x8*)(src + vt * 8192 + sr * 128 + sc); st[2 * vt + 1] = *(const s16x8*)(src + vt * 8192 + (32 + sr) * 128 + sc); }
#pragma unroll
        for (int vt = 0; vt < 4; ++vt) { *(s16x8*)(lds + vt * 16384 + vst0) = st[2 * vt]; *(s16x8*)(lds + vt * 16384 + vst1) = st[2 * vt + 1]; }
        __syncthreads();
        f32x16 od0 = {}, od1 = {};
#pragma unroll
        for (int vt = 0; vt < 4; ++vt) {
            const s16x8* tp = T128 + ((rt * 4 + vt) * 4) * 64 + lane;
            const s16x8 pa0 = tp[0], pa1 = tp[64], pa2 = tp[128], pa3 = tp[192];
            att::pv_one_f16(od0, vb + vt * 16384, pa0, pa1, pa2, pa3);
            att::pv_one_f16(od1, vb + vt * 16384 + 512, pa0, pa1, pa2, pa3);
        }
#pragma unroll
        for (int dd = 0; dd < 2; ++dd)
#pragma unroll
            for (int r = 0; r < 16; ++r) {
                const int k = k1 + 64 * (32 * rt + crow(r, hi)), l = 32 * (2 * cbp + dd) + r32; const size_t tok = (size_t)b * SEQ + k;
                const float z = bflo((unsigned)P[tok * N0 + 2560 + g * 128 + l]);
                const float f = (dd ? od1[r] : od0[r]) * (1.0f / 1024.0f);
                Y[tok * DM + 512 + g * 128 + l] = (u16)f2bf(f * silu(z));
            }
        __syncthreads();
    }
}

__device__ __forceinline__ void p6_qknorm(const Args& a, int gtid, int ngt) {
    u16* P = (u16*)(a.ws + WS_PROJ); const f32x2* TR = (const f32x2*)(a.ws + WS_TROPE); const float* qg = a.in[7]; const float* kg = a.in[8];
    for (int idx = gtid; idx < M * 10 * 16; idx += ngt) {
        const int li = idx & 15, th = idx >> 4, hh = th % 10, t = th / 10, s = t & (SEQ - 1);
        u16* p = P + (size_t)t * N1 + (hh < 8 ? hh * 128 : 1024 + (hh - 8) * 128) + 8 * li;
        const float* gn = (hh < 8 ? qg : kg) + 8 * li;
        float v[8]; unpack8(*(const v4u*)p, v);
        float ss = 0.f;
#pragma unroll
        for (int i = 0; i < 8; ++i) ss += v[i] * v[i];
        ss += __shfl_xor(ss, 1); ss += __shfl_xor(ss, 2); ss += __shfl_xor(ss, 4); ss += __shfl_xor(ss, 8);
        const float r = 1.0f / sqrtf(ss * (1.0f / 128.0f) + EPS);
        const f32x4 g0 = *(const f32x4*)gn, g1 = *(const f32x4*)(gn + 4);
#pragma unroll
        for (int i = 0; i < 4; ++i) { v[i] = v[i] * r * g0[i]; v[4 + i] = v[4 + i] * r * g1[i]; }
        float o[8];
#pragma unroll
        for (int i = 0; i < 4; ++i) { const int pr = 4 * li + i; const f32x2 cs = pr < 32 ? TR[(s >> 6) * 32 + pr] : TR[(s & 63) * 32 + pr - 32];
            o[2 * i] = v[2 * i] * cs[0] - v[2 * i + 1] * cs[1]; o[2 * i + 1] = v[2 * i] * cs[1] + v[2 * i + 1] * cs[0]; }
        v4u w; w.x = pk2(o[0], o[1]); w.y = pk2(o[2], o[3]); w.z = pk2(o[4], o[5]); w.w = pk2(o[6], o[7]);
        *(v4u*)p = w;
    }
}

__device__ __forceinline__ void p9_final(const Args& a, int gw, int NGW, int lane) {
    float* out = a.out; const float* gf = a.in[10];
    f32x4 gv[4];
#pragma unroll
    for (int j = 0; j < 4; ++j) gv[j] = ((const f32x4*)gf)[lane + 64 * j];
    for (int m = gw; m < M; m += NGW) {
        f32x4* xr = (f32x4*)(out + (size_t)m * DM) + lane; f32x4 v[4]; float s = 0.f;
#pragma unroll
        for (int j = 0; j < 4; ++j) { v[j] = xr[64 * j]; s += (v[j][0] * v[j][0] + v[j][1] * v[j][1]) + (v[j][2] * v[j][2] + v[j][3] * v[j][3]); }
        const float r = 1.0f / sqrtf(wave_sum(s) * (1.0f / DM) + EPS);
#pragma unroll
        for (int j = 0; j < 4; ++j) xr[64 * j] = v[j] * r * gv[j];
    }
}

#ifndef MK_PG8_ALIGN
#define MK_PG8_ALIGN true
#endif
#ifndef MK_PG8_SP2
#define MK_PG8_SP2 true
#endif
__global__ void __launch_bounds__(NTHR, 2) enc_fwd(Args args) {
    extern __shared__ __attribute__((aligned(16))) unsigned char lds_raw[];
    LAS unsigned char* lds = (LAS unsigned char*)lds_raw;
    const int tid = threadIdx.x, lane = tid & 63, wave = __builtin_amdgcn_readfirstlane(tid >> 6);
    const int G = gridDim.x, bid = blockIdx.x;
    const int gw = bid * NWAVES + wave, NGW = G * NWAVES, gtid = bid * NTHR + tid, ngt = G * NTHR;
    unsigned char* ws = args.ws;
    volatile LAS unsigned* MISC = (volatile LAS unsigned*)(lds + MISC_OFF);
    for (int u = tid; u < (LDS_BYTES - RING_BYTES) / 4; u += NTHR) ((LAS unsigned*)(lds + RING_BYTES))[u] = 0u;
    __syncthreads();
    const int lo = args.ph_lo, hi = args.ph_hi;
    const bool multi = (hi - lo) > 1;
    XcdBarrier bar; bar.bar = (unsigned*)(ws + WS_CTL) + CW_BAR; bar.x = 0; bar.st = nullptr;
    if (multi && args.coop == 1) bar = xcd_barrier_post((unsigned*)(ws + WS_CTL) + CW_BAR, MISC + 8);
#define IN(k) (lo <= (k) && (k) < hi)
#define SEAM(k) do { if (IN(k) && IN((k) + 1)) { if (args.coop == 2) cg::this_grid().sync(); else xcd_barrier(bar); } } while (0)

    if (IN(0)) { p0_prologue(args, lds, gw, NGW, wave, lane); }
    SEAM(0);
    if (IN(1)) {
        pg8::Gemm g{(const pg8::bf16_t*)(ws + WS_XN), (const pg8::bf16_t*)(ws + WS_W0IN), M, N0, DM}; pg8::StaticOrder S; S.init(M, N0, G, bid);
        pg8::EpiScale E{(pg8::bf16_t*)(ws + WS_PROJ), N0, nullptr, 2048, 2560, EPS};
        pg8::gemm_phase<pg8::EpiScale, pg8::StaticOrder, MK_PG8_ALIGN, MK_PG8_SP2>(lds, g, S, E);
    }
    SEAM(1);
    if (IN(2)) { p2_fft1(args, G, wave, lane); p2_conv(args, gtid, ngt); }
    SEAM(2);
    if (IN(3)) { p3_fft2(args, lds_raw, G, tid, wave, lane); }
    SEAM(3);
    if (IN(4)) {
        pg8::Gemm g{(const pg8::bf16_t*)(ws + WS_YCAT), (const pg8::bf16_t*)(ws + WS_W0OUT), M, DM, DM}; pg8::StaticOrder S; S.init(M, DM, G, bid);
        pg8::EpiResid E{args.in[0], args.out, (pg8::bf16_t*)(ws + WS_XN), args.in[5], (float*)(ws + WS_SSP), DM};
        pg8::gemm_phase<pg8::EpiResid, pg8::StaticOrder, MK_PG8_ALIGN, MK_PG8_SP2>(lds, g, S, E);
    }
    SEAM(4);
    if (IN(5)) {
        pg8::Gemm g{(const pg8::bf16_t*)(ws + WS_XN), (const pg8::bf16_t*)(ws + WS_W1IN), M, N1, DM}; pg8::StaticOrder S; S.init(M, N1, G, bid);
        pg8::EpiScale E{(pg8::bf16_t*)(ws + WS_PROJ), N1, (const float*)(ws + WS_SSP), -1, -1, EPS};
        pg8::gemm_phase<pg8::EpiScale, pg8::StaticOrder, MK_PG8_ALIGN, MK_PG8_SP2>(lds, g, S, E);
    }
    SEAM(5);
    if (IN(6)) { p6_qknorm(args, gtid, ngt); }
    SEAM(6);
    if (IN(7)) {
        const att::bf16* P = (const att::bf16*)(ws + WS_PROJ); att::bf16* O = (att::bf16*)(ws + WS_YCAT);
        for (int i = bid; i < 512; i += G) {
            const int b = i >> 8, r = i & 255, x = r & 7, qb = r >> 3, h = 4 * (x & 1) + (x >> 1), kvh = h >> 2;
            const size_t row0 = (size_t)b * SEQ + (size_t)qb * 256;
            att::attn_dense_body(P + row0 * N1 + h * 128, P + (size_t)b * SEQ * N1 + 1024 + kvh * 128, P + (size_t)b * SEQ * N1 + 1280 + kvh * 128,
                                 P + row0 * N1 + 1536 + h * 128, O + row0 * DM + h * 128, SEQ, (char*)lds_raw);
            __syncthreads();
        }
    }
    SEAM(7);
    if (IN(8)) {
        pg8::Gemm g{(const pg8::bf16_t*)(ws + WS_YCAT), (const pg8::bf16_t*)(ws + WS_W1OUT), M, DM, DM}; pg8::StaticOrder S; S.init(M, DM, G, bid);
        pg8::EpiResid E{args.out, args.out, nullptr, nullptr, nullptr, DM};
        pg8::gemm_phase<pg8::EpiResid, pg8::StaticOrder, MK_PG8_ALIGN, MK_PG8_SP2>(lds, g, S, E);
    }
    SEAM(8);
    if (IN(9)) { p9_final(args, gw, NGW, lane); }
#undef IN
#undef SEAM
}

#ifndef MK_ONE_LAUNCH
#define MK_ONE_LAUNCH 0
#endif
extern "C" void kernel_launch(void* const* d_in, const int* in_sizes, int n_in, void* d_out, int out_size, void* d_ws, size_t ws_size, hipStream_t stream) {
    static int grid = 0;
    if (grid == 0) {
        if (n_in != 11 || in_sizes[0] != M * DM || out_size != M * DM || ws_size < WS_END) { fprintf(stderr, "kernel_launch: shape mismatch (n_in %d, in0 %d, out %d, ws %zu)\n", n_in, n_in > 0 ? in_sizes[0] : -1, out_size, ws_size); grid = -1; return; }
        int dev = 0, cus = 0, per_cu = 0;
        if (hipGetDevice(&dev) != hipSuccess || hipDeviceGetAttribute(&cus, hipDeviceAttributeMultiprocessorCount, dev) != hipSuccess) { grid = -1; return; }
        if (hipFuncSetAttribute((const void*)enc_fwd, hipFuncAttributeMaxDynamicSharedMemorySize, LDS_BYTES) != hipSuccess) { fprintf(stderr, "kernel_launch: hipFuncSetAttribute failed\n"); grid = -1; return; }
        if (hipOccupancyMaxActiveBlocksPerMultiprocessor(&per_cu, (const void*)enc_fwd, NTHR, LDS_BYTES) != hipSuccess || per_cu < 1) { fprintf(stderr, "kernel_launch: occupancy query says %d\n", per_cu); per_cu = 1; }
        (void)hipGetLastError();
        grid = cus * per_cu;
    }
    if (grid < 0) return;
    Args a{};
    for (int i = 0; i < 11; ++i) a.in[i] = (const float*)d_in[i];
    a.out = (float*)d_out; a.ws = (unsigned char*)d_ws;
#if MK_ONE_LAUNCH
    if (hipMemsetAsync((char*)d_ws + WS_CTL, 0, CTL_ZERO_BYTES, stream) != hipSuccess) { fprintf(stderr, "kernel_launch: memset failed\n"); return; }
    a.ph_lo = 0; a.ph_hi = 10; a.coop = MK_ONE_LAUNCH;
    void* kargs[] = {&a};
    const hipError_t e = hipLaunchCooperativeKernel((const void*)enc_fwd, dim3(grid), dim3(NTHR), kargs, LDS_BYTES, stream);
    if (e != hipSuccess) fprintf(stderr, "kernel_launch: cooperative launch failed: %s (grid %d)\n", hipGetErrorString(e), grid);
#else
    for (int p = 0; p < 10; ++p) {
        a.ph_lo = p; a.ph_hi = p + 1; a.coop = 0;
        hipLaunchKernelGGL(enc_fwd, dim3(grid), dim3(NTHR), LDS_BYTES, stream, a);
    }
    const hipError_t le = hipPeekAtLastError();
    if (le != hipSuccess) fprintf(stderr, "kernel_launch: launch failed: %s\n", hipGetErrorName(le));
#endif
}
```
